# Optimizing an MI355X kernel written in HIP

```python
import math
import jax, jax.numpy as jnp
from jax import lax
import numpy as np

D_MODEL = 1024
BATCH = 2
SEQ = 16384
DEPTH = 2

RG_WIDTH = 512
RG_BLOCKS = 8
RG_BLOCK_DIM = RG_WIDTH // RG_BLOCKS
CONV_WIDTH = 4
RG_C = 8.0
GLA_HEADS = 4
GLA_DK = 64
GLA_DV = 128
GLA_RANK = 16
GLA_GATE_NORMALIZER = 16.0
HG_HEADS = 4
HG_DK = 128
HG_DV = 128
HG_F_MIN = 1e-30
N_BRANCHES = 3
BRANCH_WIDTH = 512
CHUNK = 64
D_FF = 2816
N_EXPERTS = 8
TOP_K = 2
D_FF_EXPERT = 3584
MOE_BLOCK = 512
N_DENSE = (DEPTH + 1) // 2
N_MOE = DEPTH // 2
ALPHA = (2 * DEPTH) ** 0.25
BETA = (8 * DEPTH) ** -0.25
LN_EPS = 1e-5
RMS_EPS = 1e-6

SPLIT_SIZES = (RG_WIDTH,
               GLA_HEADS * GLA_DK, GLA_HEADS * GLA_DK, GLA_HEADS * GLA_DV, GLA_RANK, GLA_HEADS * GLA_DV,
               HG_HEADS * HG_DK, HG_HEADS * HG_DK, HG_HEADS * HG_DV, HG_HEADS * HG_DV,
               N_BRANCHES * D_MODEL)
D_IN = sum(SPLIT_SIZES)
SPLIT_POINTS = tuple(sum(SPLIT_SIZES[:i + 1]) for i in range(len(SPLIT_SIZES) - 1))

kernel_name = 'hybrid_rglru_gla_hgrn2_moe_deepnorm'


def layer_norm(x, g, b):
    xf = x.astype(jnp.float32)
    mu = jnp.mean(xf, axis=-1, keepdims=True)
    var = jnp.mean(jnp.square(xf - mu), axis=-1, keepdims=True)
    y = (xf - mu) * lax.rsqrt(var + LN_EPS) * g.astype(jnp.float32) + b.astype(jnp.float32)
    return y.astype(x.dtype)


def rms_norm(x, w):
    xf = x.astype(jnp.float32)
    return xf * lax.rsqrt(jnp.mean(xf * xf, axis=-1, keepdims=True) + RMS_EPS) * w.astype(jnp.float32)


def chunked_gated_linear_attention(q, k, v, log_g, scale):
    B, S, H, K = q.shape
    V = v.shape[-1]
    N = S // CHUNK

    def chunks(t):
        return t.astype(jnp.float32).reshape(B, N, CHUNK, H, t.shape[-1]).transpose(1, 0, 3, 2, 4)

    qc, kc, vc = chunks(q * scale), chunks(k), chunks(v)
    G = jnp.cumsum(chunks(log_g), axis=3)
    causal = jnp.tril(jnp.ones((CHUNK, CHUNK), dtype=bool))[:, :, None]

    def step(state, inp):
        qi, ki, vi, Gi = inp
        o_inter = jnp.einsum('bhck,bhkv->bhcv', qi * jnp.exp(Gi), state)
        diff = jnp.where(causal, Gi[:, :, :, None, :] - Gi[:, :, None, :, :], 0.0)
        decay = jnp.where(causal, jnp.exp(diff), 0.0)
        scores = jnp.einsum('bhck,bhsk,bhcsk->bhcs', qi, ki, decay)
        o_intra = jnp.einsum('bhcs,bhsv->bhcv', scores, vi)
        G_last = Gi[:, :, -1:, :]
        k_dec = ki * jnp.exp(G_last - Gi)
        state = state * jnp.exp(G_last[:, :, 0, :, None]) + jnp.einsum('bhsk,bhsv->bhkv', k_dec, vi)
        return state, o_inter + o_intra

    state0 = jnp.zeros((B, H, K, V), jnp.float32)
    _, o = lax.scan(step, state0, (qc, kc, vc, G))
    return o.transpose(1, 0, 3, 2, 4).reshape(B, S, H, V)


def rglru_branch(u, conv_w, conv_b, w_r, b_r, w_i, b_i, lam):
    B, S, W = u.shape
    u_pad = jnp.pad(u, ((0, 0), (CONV_WIDTH - 1, 0), (0, 0)))
    c = conv_b
    for j in range(CONV_WIDTH):
        c = c + u_pad[:, j:j + S] * conv_w[j]
    cb = c.reshape(B, S, RG_BLOCKS, RG_BLOCK_DIM)
    r = jax.nn.sigmoid(jnp.einsum('bsgi,gij->bsgj', cb, w_r).reshape(B, S, W) + b_r).astype(jnp.float32)
    i = jax.nn.sigmoid(jnp.einsum('bsgi,gij->bsgj', cb, w_i).reshape(B, S, W) + b_i).astype(jnp.float32)
    log_a = -RG_C * r * jax.nn.softplus(-lam.astype(jnp.float32))
    a = jnp.exp(log_a)
    b = jnp.sqrt(jnp.maximum(-jnp.expm1(2.0 * log_a), 0.0)) * (i * c.astype(jnp.float32))

    def combine(left, right):
        return left[0] * right[0], right[0] * left[1] + right[1]

    _, h = lax.associative_scan(combine, (a, b), axis=1)
    return h.astype(u.dtype)


def gla_branch(q, k, v, a_low, g, w_a, b_a, norm_w):
    B, S, _ = q.shape
    log_alpha = jax.nn.log_sigmoid((a_low @ w_a + b_a).astype(jnp.float32)) / GLA_GATE_NORMALIZER
    o = chunked_gated_linear_attention(
        q.reshape(B, S, GLA_HEADS, GLA_DK), k.reshape(B, S, GLA_HEADS, GLA_DK),
        v.reshape(B, S, GLA_HEADS, GLA_DV), log_alpha.reshape(B, S, GLA_HEADS, GLA_DK), GLA_DK ** -0.5)
    o = rms_norm(o, norm_w).reshape(B, S, GLA_HEADS * GLA_DV)
    return (o * jax.nn.silu(g.astype(jnp.float32))).astype(q.dtype)


def hgrn2_branch(q, f, i, g, lower_bound, norm_w):
    B, S, _ = q.shape
    z = f.astype(jnp.float32)
    forget = lower_bound + (1.0 - lower_bound) * jax.nn.sigmoid(z)
    log_f = jnp.log(jnp.maximum(forget, HG_F_MIN))
    k = (1.0 - lower_bound) * jax.nn.sigmoid(-z)
    qs = jax.nn.silu(q.astype(jnp.float32))
    o = chunked_gated_linear_attention(
        qs.reshape(B, S, HG_HEADS, HG_DK), k.reshape(B, S, HG_HEADS, HG_DK),
        i.reshape(B, S, HG_HEADS, HG_DV), log_f.reshape(B, S, HG_HEADS, HG_DK), HG_DK ** -0.5)
    o = rms_norm(o.reshape(B, S, HG_HEADS * HG_DV), norm_w)
    return (o * jax.nn.sigmoid(g.astype(jnp.float32))).astype(q.dtype)


def token_mixer(x, w_in, conv_w, conv_b, rg_wr, rg_br, rg_wi, rg_bi, rg_lambda,
                gla_wa, gla_ba, gla_norm_w, lower_bound, hg_norm_w, w_branch, w_out):
    B, S, _ = x.shape
    proj = x @ w_in
    (rg_x, gq, gk, gv, ga, gg, hq, hf, hi, hg, gates) = jnp.split(proj, SPLIT_POINTS, axis=-1)
    y_rg = rglru_branch(rg_x, conv_w, conv_b, rg_wr, rg_br, rg_wi, rg_bi, rg_lambda)
    y_gla = gla_branch(gq, gk, gv, ga, gg, gla_wa, gla_ba, gla_norm_w)
    y_hg = hgrn2_branch(hq, hf, hi, hg, lower_bound, hg_norm_w)
    ys = jnp.stack([y_rg, y_gla, y_hg], axis=2)
    branch_out = jnp.einsum('bsnw,nwd->bsnd', ys, w_branch)
    merge = jax.nn.sigmoid(gates.reshape(B, S, N_BRANCHES, D_MODEL))
    mixed = jnp.sum(merge * branch_out, axis=2)
    return mixed @ w_out


def swiglu(x, w_gate, w_up, w_down):
    return (jax.nn.silu(x @ w_gate) * (x @ w_up)) @ w_down


def moe_swiglu(x, router_w, w_gate, w_up, w_down):
    B, S, D = x.shape
    T = B * S
    TK = T * TOP_K
    xf = x.reshape(T, D)
    logits = (xf @ router_w).astype(jnp.float32)
    top_logits, top_idx = lax.top_k(logits, TOP_K)
    top_w = jax.nn.softmax(top_logits, axis=-1)
    expert = top_idx.reshape(-1).astype(jnp.int32)
    token = jnp.repeat(jnp.arange(T, dtype=jnp.int32), TOP_K)
    weight = top_w.reshape(-1)
    order = jnp.argsort(expert, stable=True)
    e_sorted = expert[order]
    counts = jnp.bincount(expert, length=N_EXPERTS).astype(jnp.int32)
    padded = (counts + MOE_BLOCK - 1) // MOE_BLOCK * MOE_BLOCK
    start = jnp.cumsum(counts) - counts
    pad_end = jnp.cumsum(padded)
    pad_start = pad_end - padded
    dest = pad_start[e_sorted] + jnp.arange(TK, dtype=jnp.int32) - start[e_sorted]
    n_blocks = -(-TK // MOE_BLOCK) + N_EXPERTS
    P = n_blocks * MOE_BLOCK
    buf_tok = jnp.zeros((P,), jnp.int32).at[dest].set(token[order])
    buf_w = jnp.zeros((P,), jnp.float32).at[dest].set(weight[order])
    block_start = jnp.arange(n_blocks, dtype=jnp.int32) * MOE_BLOCK
    block_expert = jnp.minimum(jnp.searchsorted(pad_end, block_start, side='right'), N_EXPERTS - 1)
    xs = xf[buf_tok].reshape(n_blocks, MOE_BLOCK, D)

    def expert_block(args):
        xb, e = args
        return swiglu(xb, w_gate[e], w_up[e], w_down[e])

    ys = lax.map(expert_block, (xs, block_expert)).reshape(P, D)
    y = jnp.zeros((T, D), ys.dtype).at[buf_tok].add(ys * buf_w[:, None].astype(ys.dtype))
    return y.reshape(B, S, D).astype(x.dtype)


def setup_inputs(seed: int = 0) -> dict:
    key = jax.random.key(seed)
    ks = jax.random.split(key, 28)
    f32 = jnp.float32

    def dense(k, shape, fan_in, scale=1.0):
        return jax.random.normal(k, shape, f32) * (scale * fan_in ** -0.5)

    def small(k, shape):
        return 0.01 * jax.random.normal(k, shape, f32)

    def gain(k, shape):
        return 1.0 + 0.01 * jax.random.normal(k, shape, f32)

    hk = GLA_HEADS * GLA_DK
    a_pow = jax.random.uniform(ks[9], (DEPTH, RG_WIDTH), f32, 0.9, 0.999)
    a_base = a_pow ** (1.0 / RG_C)
    return {
        'x': jax.random.normal(ks[0], (BATCH, SEQ, D_MODEL), f32),
        'w_in': dense(ks[1], (DEPTH, D_MODEL, D_IN), D_MODEL),
        'conv_w': dense(ks[2], (DEPTH, CONV_WIDTH, RG_WIDTH), CONV_WIDTH),
        'conv_b': small(ks[3], (DEPTH, RG_WIDTH)),
        'rg_wr': dense(ks[4], (DEPTH, RG_BLOCKS, RG_BLOCK_DIM, RG_BLOCK_DIM), RG_BLOCK_DIM),
        'rg_br': small(ks[5], (DEPTH, RG_WIDTH)),
        'rg_wi': dense(ks[6], (DEPTH, RG_BLOCKS, RG_BLOCK_DIM, RG_BLOCK_DIM), RG_BLOCK_DIM),
        'rg_bi': small(ks[7], (DEPTH, RG_WIDTH)),
        'rg_lambda': jnp.log(a_base) - jnp.log1p(-a_base),
        'gla_wa': dense(ks[8], (DEPTH, GLA_RANK, hk), GLA_RANK),
        'gla_ba': small(ks[10], (DEPTH, hk)),
        'gla_norm_w': gain(ks[11], (DEPTH, GLA_DV)),
        'hg_lb_logits': 0.1 * jax.random.normal(ks[12], (DEPTH, HG_HEADS * HG_DK), f32),
        'hg_norm_w': gain(ks[13], (DEPTH, HG_HEADS * HG_DV)),
        'w_branch': dense(ks[14], (DEPTH, N_BRANCHES, BRANCH_WIDTH, D_MODEL), BRANCH_WIDTH, BETA),
        'w_out': dense(ks[15], (DEPTH, D_MODEL, D_MODEL), D_MODEL, BETA),
        'ln1_g': gain(ks[16], (DEPTH, D_MODEL)),
        'ln1_b': small(ks[17], (DEPTH, D_MODEL)),
        'ln2_g': gain(ks[18], (DEPTH, D_MODEL)),
        'ln2_b': small(ks[19], (DEPTH, D_MODEL)),
        'ffn_wg': dense(ks[20], (N_DENSE, D_MODEL, D_FF), D_MODEL),
        'ffn_wu': dense(ks[21], (N_DENSE, D_MODEL, D_FF), D_MODEL),
        'ffn_wd': dense(ks[22], (N_DENSE, D_FF, D_MODEL), D_FF, BETA),
        'router_w': dense(ks[23], (N_MOE, D_MODEL, N_EXPERTS), D_MODEL),
        'moe_wg': dense(ks[24], (N_MOE, N_EXPERTS, D_MODEL, D_FF_EXPERT), D_MODEL),
        'moe_wu': dense(ks[25], (N_MOE, N_EXPERTS, D_MODEL, D_FF_EXPERT), D_MODEL),
        'moe_wd': dense(ks[26], (N_MOE, N_EXPERTS, D_FF_EXPERT, D_MODEL), D_FF_EXPERT, BETA),
    }


def reference(x, w_in, conv_w, conv_b, rg_wr, rg_br, rg_wi, rg_bi, rg_lambda,
              gla_wa, gla_ba, gla_norm_w, hg_lb_logits, hg_norm_w, w_branch, w_out,
              ln1_g, ln1_b, ln2_g, ln2_b, ffn_wg, ffn_wu, ffn_wd,
              router_w, moe_wg, moe_wu, moe_wd):
    lb_w = jax.nn.softmax(hg_lb_logits.astype(jnp.float32), axis=0)
    lower_bounds = jnp.cumsum(lb_w, axis=0) - lb_w[0]
    for l in range(DEPTH):
        h = token_mixer(x, w_in[l], conv_w[l], conv_b[l], rg_wr[l], rg_br[l], rg_wi[l], rg_bi[l],
                        rg_lambda[l], gla_wa[l], gla_ba[l], gla_norm_w[l], lower_bounds[l],
                        hg_norm_w[l], w_branch[l], w_out[l])
        x = layer_norm(ALPHA * x + h, ln1_g[l], ln1_b[l])
        j = l // 2
        if l % 2 == 0:
            f = swiglu(x, ffn_wg[j], ffn_wu[j], ffn_wd[j])
        else:
            f = moe_swiglu(x, router_w[j], moe_wg[j], moe_wu[j], moe_wd[j])
        x = layer_norm(ALPHA * x + f, ln2_g[l], ln2_b[l])
    return x
```

```cpp
#include <hip/hip_runtime.h>
#include <cstdio>
#include <cstdint>
namespace pg8 {
#define PG8_LAS __attribute__((address_space(3)))
typedef unsigned short bf16_t;
typedef short bf16x8 __attribute__((ext_vector_type(8)));
typedef float f32x4 __attribute__((ext_vector_type(4)));
typedef unsigned u32x4 __attribute__((ext_vector_type(4)));
constexpr int BM = 256, BK = 64, HALF = 128, HTB = HALF * BK * 2  , STAGE_BYTES = 8 * HTB, NXCD = 8, WGM = 8;

__host__ __device__ __forceinline__ int lds_byte(int r, int c) { const int st = (r >> 4) * 2 + (c >> 5), rr = r & 15, cc = c & 31, ob = rr * 64 + cc * 2; return st * 1024 + (ob ^ (((ob >> 9) & 1) << 5)); }
__host__ __device__ __forceinline__ void stage_rc(int b, int& R, int& C) { const int st = b / 1024, sb = b % 1024, swz = sb ^ (((sb >> 9) & 1) << 5); R = (st >> 1) * 16 + swz / 64; C = (st & 1) * 32 + (swz % 64) / 2; }
__host__ __device__ __forceinline__ int perm32(int rho) { const int n = rho >> 4, i = rho & 15; return 8 * (i >> 2) + 4 * n + (i & 3); }

struct Unit { int pm, pn, aux; };
struct Gemm { const bf16_t* A; const bf16_t* Bt; int M, N, K, lda; };

struct StaticOrder {
    int nM, nN, nwg, G, c;
    __host__ __device__ void init(int M, int N, int G_, int c_) { nM = M / BM; nN = N / BM; nwg = nM * nN; G = G_; c = c_; }
    __host__ __device__ bool next(int i, Unit& u) const {
        const long L = (long)i * G + c; if (L >= nwg) return false;
        int wgid = (int)L; { const int q = nwg / NXCD, r = nwg % NXCD, xcd = wgid % NXCD, off = wgid / NXCD; wgid = (xcd < r ? xcd * (q + 1) : r * (q + 1) + (xcd - r) * q) + off; }
        const int nig = WGM * nN, gid = wgid / nig, fm = gid * WGM, gsz = (nM - fm) < WGM ? (nM - fm) : WGM;
        u.pm = fm + ((wgid % nig) % gsz); u.pn = (wgid % nig) / gsz; u.aux = u.pn; return true;
    }
    __device__ __forceinline__ void a_ready(const Unit&) const {}
    __device__ __forceinline__ void done(const Unit&) const {}
};

typedef float f32x2_cv __attribute__((ext_vector_type(2))); typedef __bf16 bf16x2_cv __attribute__((ext_vector_type(2)));
__device__ __forceinline__ unsigned cvt_pk_bf16(float lo, float hi) { f32x2_cv v = {lo, hi}; bf16x2_cv b = __builtin_convertvector(v, bf16x2_cv); return __builtin_bit_cast(unsigned, b); }
typedef float f32x2 __attribute__((ext_vector_type(2)));
__device__ __forceinline__ f32x2 gelu_pk(f32x2 v) {
    const f32x2 av = __builtin_elementwise_abs(v), d = av * 0.2316418882f + 1.0f;
    f32x2 t; t.x = __builtin_amdgcn_rcpf(d.x); t.y = __builtin_amdgcn_rcpf(d.y);
    f32x2 q = t * 0.5307027145f + (-0.7265760135f); q = q * t + 0.7107068705f; q = q * t + (-0.142248368f); q = q * t + 0.127414796f; q = q * t;
    const f32x2 s = (v * v) * (-0.72134752044f);
    f32x2 e; e.x = __builtin_amdgcn_exp2f(s.x); e.y = __builtin_amdgcn_exp2f(s.y);
    const f32x2 m = v * (q * e), r = v - m;
    f32x2 o; o.x = v.x < 0.f ? m.x : r.x; o.y = v.y < 0.f ? m.y : r.y; return o;
}

template <int ACT  > struct EpiBf16 {
    static constexpr bool PERM = true, AFTER_DRAIN = false; static_assert(ACT == 0 || ACT == 1, "EpiBf16: ACT is 0 (none) or 1 (gelu_pk)");
    bf16_t* O; int ldc; const float* bias; int split_cols; size_t split_stride; float scale0;
    __device__ __forceinline__ void operator()(const f32x4 (&acc)[2][2][4][2], const Unit& u, int wr, int wc, int fr, int fq) const {
        const int row0 = u.pm * BM + wr * 64 + fr; int colt = u.pn * BM; bf16_t* base = O;
        float sc = 1.f; if (split_cols) { const int t = colt / split_cols; base += (size_t)t * split_stride; colt -= t * split_cols; if (t == 0) sc = scale0; }
        const int col0 = colt + wc * 32 + 8 * fq, bcol0 = u.pn * BM + wc * 32 + 8 * fq;
        f32x4 bv[2][2];
#pragma unroll
        for (int bj = 0; bj < 2; ++bj)
#pragma unroll
            for (int n = 0; n < 2; ++n) bv[bj][n] = bias ? *(const f32x4*)(bias + bcol0 + bj * HALF + 4 * n) : (f32x4){0.f, 0.f, 0.f, 0.f};
#pragma unroll
        for (int ai = 0; ai < 2; ++ai)
#pragma unroll
            for (int m = 0; m < 4; ++m) { bf16_t* rowp = base + (size_t)(row0 + ai * HALF + m * 16) * ldc + col0;
#pragma unroll
                for (int bj = 0; bj < 2; ++bj) { f32x4 v0 = acc[ai][bj][m][0] + bv[bj][0], v1 = acc[ai][bj][m][1] + bv[bj][1];
                    if (ACT == 1) { f32x2 a = gelu_pk((f32x2){v0[0], v0[1]}), b = gelu_pk((f32x2){v0[2], v0[3]}), c = gelu_pk((f32x2){v1[0], v1[1]}), d = gelu_pk((f32x2){v1[2], v1[3]});
                        v0 = (f32x4){a.x, a.y, b.x, b.y}; v1 = (f32x4){c.x, c.y, d.x, d.y}; }
                    v0 = v0 * sc; v1 = v1 * sc; u32x4 w; w.x = cvt_pk_bf16(v0[0], v0[1]); w.y = cvt_pk_bf16(v0[2], v0[3]); w.z = cvt_pk_bf16(v1[0], v1[1]); w.w = cvt_pk_bf16(v1[2], v1[3]);
                    *(u32x4*)(rowp + bj * HALF) = w; } }
    }
};

struct PanelStats {
    unsigned* xbuf;
    unsigned* cnt;
    unsigned* tmo;
    int ntn; float eps;
    unsigned code;
    __device__ __forceinline__ bool run(const f32x4 (&v)[2][2][4][2], const Unit& u, int wr, int wc, int fr, int fq, PG8_LAS unsigned char* lds, int wid, int lane) const {
        typedef float f32x2v __attribute__((ext_vector_type(2)));
        PG8_LAS f32x2v* P = (PG8_LAS f32x2v*)lds;
        PG8_LAS f32x2v* S = (PG8_LAS f32x2v*)(lds + 8192);
        PG8_LAS unsigned* flag = (PG8_LAS unsigned*)(lds + 8192 + 2048);
#pragma unroll
        for (int ai = 0; ai < 2; ++ai)
#pragma unroll
            for (int m = 0; m < 4; ++m) {
                float s = 0.f;
#pragma unroll
                for (int bj = 0; bj < 2; ++bj)
#pragma unroll
                    for (int n = 0; n < 2; ++n) { const f32x4 x = v[ai][bj][m][n]; s += (x[0] + x[1]) + (x[2] + x[3]); }
                s += __shfl_xor(s, 16); s += __shfl_xor(s, 32);
                const float mw = s * (1.0f / 64.0f); float q = 0.f;
#pragma unroll
                for (int bj = 0; bj < 2; ++bj)
#pragma unroll
                    for (int n = 0; n < 2; ++n) { const f32x4 d = v[ai][bj][m][n] - mw; q += (d[0] * d[0] + d[1] * d[1]) + (d[2] * d[2] + d[3] * d[3]); }
                q += __shfl_xor(q, 16); q += __shfl_xor(q, 32);
                if (fq == 0) P[(ai * HALF + wr * 64 + m * 16 + fr) * 4 + wc] = (f32x2v){mw, q};
            }
        asm volatile("s_waitcnt lgkmcnt(0)" ::: "memory"); __builtin_amdgcn_s_barrier(); asm volatile("" ::: "memory");
#if defined(BROKEN_EXCHANGE_NO_WAIT)
#warning BROKEN CONTROL BUILD: the row-statistics exchange does not wait; results are wrong by design
        if (blockIdx.x >= 64) { const long long t0_ = clock64(); while (clock64() - t0_ < 60000) __builtin_amdgcn_s_sleep(8); }
#endif
        const int row = wid * 32 + (lane & 31);
        if (lane < 32) {
            const f32x2v a = P[row * 4 + 0], b = P[row * 4 + 1], c = P[row * 4 + 2], d = P[row * 4 + 3];
            const float mt = (a.x + b.x + c.x + d.x) * 0.25f;
            const float da = a.x - mt, db = b.x - mt, dc = c.x - mt, dd = d.x - mt;
            const float m2 = (a.y + b.y) + (c.y + d.y) + 64.0f * ((da * da + db * db) + (dc * dc + dd * dd));
            unsigned long long* slot = (unsigned long long*)xbuf + ((size_t)(u.pm * BM + row) * 4 + u.pn);
            __hip_atomic_store(slot, ((unsigned long long)__float_as_uint(m2) << 32) | __float_as_uint(mt), __ATOMIC_RELAXED, __HIP_MEMORY_SCOPE_AGENT);
        }
        asm volatile("s_waitcnt vmcnt(0)" ::: "memory");
        if (lane == 0) __hip_atomic_fetch_add(cnt + 64 * u.pm, 1u, __ATOMIC_RELAXED, __HIP_MEMORY_SCOPE_AGENT);
        if (wid == 0) {
            bool dead = false; const unsigned long long t0 = __builtin_amdgcn_s_memrealtime(); const unsigned want = 8u * (unsigned)ntn;
            for (;;) {
#if defined(BROKEN_EXCHANGE_NO_WAIT)
                break;
#endif
                if ((unsigned)__builtin_amdgcn_readfirstlane(__hip_atomic_load(cnt + 64 * u.pm, __ATOMIC_RELAXED, __HIP_MEMORY_SCOPE_AGENT)) >= want) break;
                if (__builtin_amdgcn_s_memrealtime() - t0 > 2000000ull) {
                    if (lane == 0) { unsigned expect = 0u; __hip_atomic_compare_exchange_strong(tmo + 1, &expect, code | (unsigned)(u.pm & 0xff), __ATOMIC_RELAXED, __ATOMIC_RELAXED, __HIP_MEMORY_SCOPE_AGENT);
                                     __hip_atomic_store(tmo, 1u, __ATOMIC_RELAXED, __HIP_MEMORY_SCOPE_AGENT); }
                    dead = true; break; }
                __builtin_amdgcn_s_sleep(2);
            }
            __builtin_amdgcn_fence(__ATOMIC_ACQUIRE, "agent");
            if (lane == 0) flag[0] = dead ? 1u : 0u;
        }
        asm volatile("s_waitcnt vmcnt(0) lgkmcnt(0)" ::: "memory"); __builtin_amdgcn_s_barrier(); asm volatile("" ::: "memory");
        const bool bad = flag[0] != 0u;
        if (lane < 32) {
            const unsigned long long* slot = (const unsigned long long*)xbuf + (size_t)(u.pm * BM + row) * 4; float mt[4], m2[4]; float ms = 0.f;
#pragma unroll
            for (int t = 0; t < 4; ++t) { if (t < ntn) { const unsigned long long w = __hip_atomic_load(slot + t, __ATOMIC_RELAXED, __HIP_MEMORY_SCOPE_AGENT); mt[t] = __uint_as_float((unsigned)w); m2[t] = __uint_as_float((unsigned)(w >> 32)); } else { mt[t] = 0.f; m2[t] = 0.f; } ms += mt[t]; }
            const float mean = ms / (float)ntn; float q = 0.f;
#pragma unroll
            for (int t = 0; t < 4; ++t) if (t < ntn) { const float dm = mt[t] - mean; q += m2[t] + 256.0f * dm * dm; }
            S[row] = (f32x2v){mean, 1.0f / sqrtf(q / (256.0f * (float)ntn) + eps)};
        }
        asm volatile("s_waitcnt lgkmcnt(0)" ::: "memory"); __builtin_amdgcn_s_barrier(); asm volatile("" ::: "memory");
        return bad;
    }
};
struct EpiLnRes {
    static constexpr bool PERM = false, AFTER_DRAIN = true;
    const float* base; float* out; int ldc; const float* bias; PanelStats st; unsigned poison;
    __device__ __forceinline__ void fused(f32x4 (&acc)[2][2][4][2], const Unit& u, int wr, int wc, int fr, int fq, PG8_LAS unsigned char* lds, int wid, int lane) const {
        typedef float f32x2v __attribute__((ext_vector_type(2)));
        const PG8_LAS f32x2v* S = (const PG8_LAS f32x2v*)(lds + 8192);
        const int col0 = u.pn * BM + wc * 32 + 4 * fq;
#pragma unroll
        for (int bj = 0; bj < 2; ++bj)
#pragma unroll
            for (int n = 0; n < 2; ++n) { const f32x4 bv = bias ? *(const f32x4*)(bias + col0 + bj * HALF + n * 16) : (f32x4){0.f, 0.f, 0.f, 0.f};
#pragma unroll
                for (int ai = 0; ai < 2; ++ai)
#pragma unroll
                    for (int m = 0; m < 4; ++m) acc[ai][bj][m][n] += bv; }
        f32x4 pre[4][2][2];
#pragma unroll
        for (int m = 0; m < 4; ++m) { const size_t off = (size_t)(u.pm * BM + wr * 64 + m * 16 + fr) * ldc + col0;
#pragma unroll
            for (int bj = 0; bj < 2; ++bj)
#pragma unroll
                for (int n = 0; n < 2; ++n) pre[m][bj][n] = *(const f32x4*)(base + off + bj * HALF + n * 16); }
        const bool bad = st.run(acc, u, wr, wc, fr, fq, lds, wid, lane) || poison != 0u;
        const float qnan = __builtin_nanf("");
#pragma unroll
        for (int ai = 0; ai < 2; ++ai)
#pragma unroll
            for (int m = 0; m < 4; ++m) { const int r = ai * HALF + wr * 64 + m * 16 + fr; const f32x2v sr = S[r]; const size_t off = (size_t)(u.pm * BM + r) * ldc + col0;
#pragma unroll
                for (int bj = 0; bj < 2; ++bj)
#pragma unroll
                    for (int n = 0; n < 2; ++n) { const f32x4 bs = ai == 0 ? pre[m][bj][n] : *(const f32x4*)(base + off + bj * HALF + n * 16); f32x4 o = bs + (acc[ai][bj][m][n] - sr.x) * sr.y;
                        if (bad) o = (f32x4){qnan, qnan, qnan, qnan}; *(f32x4*)(out + off + bj * HALF + n * 16) = o; }
                if (m & 1) asm volatile("" ::: "memory"); }
    }
};
struct EpiLnResLn {
    static constexpr bool PERM = false, AFTER_DRAIN = true;
    const float* base; float* out; bf16_t* xn; int ldc; const float* bias; PanelStats st1, st2; unsigned poison;
    __device__ __forceinline__ void fused(f32x4 (&acc)[2][2][4][2], const Unit& u, int wr, int wc, int fr, int fq, PG8_LAS unsigned char* lds, int wid, int lane) const {
        typedef float f32x2v __attribute__((ext_vector_type(2))); typedef unsigned u32x2v __attribute__((ext_vector_type(2)));
        const PG8_LAS f32x2v* S = (const PG8_LAS f32x2v*)(lds + 8192);
        const int col0 = u.pn * BM + wc * 32 + 4 * fq;
#pragma unroll
        for (int bj = 0; bj < 2; ++bj)
#pragma unroll
            for (int n = 0; n < 2; ++n) { const f32x4 bv = bias ? *(const f32x4*)(bias + col0 + bj * HALF + n * 16) : (f32x4){0.f, 0.f, 0.f, 0.f};
#pragma unroll
                for (int ai = 0; ai < 2; ++ai)
#pragma unroll
                    for (int m = 0; m < 4; ++m) acc[ai][bj][m][n] += bv; }
        bool bad = st1.run(acc, u, wr, wc, fr, fq, lds, wid, lane) || poison != 0u;
        const float qnan = __builtin_nanf("");
#pragma unroll
        for (int ai = 0; ai < 2; ++ai)
#pragma unroll
            for (int m = 0; m < 4; ++m) { const int r = ai * HALF + wr * 64 + m * 16 + fr; const f32x2v sr = S[r]; const size_t off = (size_t)(u.pm * BM + r) * ldc + col0;
#pragma unroll
                for (int bj = 0; bj < 2; ++bj)
#pragma unroll
                    for (int n = 0; n < 2; ++n) { const f32x4 bs = *(const f32x4*)(base + off + bj * HALF + n * 16); acc[ai][bj][m][n] = bs + (acc[ai][bj][m][n] - sr.x) * sr.y; }
                asm volatile("" : "+v"(acc[ai][0][m][0]), "+v"(acc[ai][0][m][1]), "+v"(acc[ai][1][m][0]), "+v"(acc[ai][1][m][1]));
                if (m & 1) asm volatile("" ::: "memory"); }
        const bool bad1 = bad;
        bad = st2.run(acc, u, wr, wc, fr, fq, lds, wid, lane) || bad;
#pragma unroll
        for (int ai = 0; ai < 2; ++ai)
#pragma unroll
            for (int m = 0; m < 4; ++m) { const int r = ai * HALF + wr * 64 + m * 16 + fr; const f32x2v sr = S[r]; const size_t off = (size_t)(u.pm * BM + r) * ldc + col0;
#pragma unroll
                for (int bj = 0; bj < 2; ++bj)
#pragma unroll
                    for (int n = 0; n < 2; ++n) { const f32x4 x1 = acc[ai][bj][m][n]; *(f32x4*)(out + off + bj * HALF + n * 16) = bad1 ? (f32x4){qnan, qnan, qnan, qnan} : x1;
                        const f32x4 o = (x1 - sr.x) * sr.y; u32x2v w; w.x = cvt_pk_bf16(o[0], o[1]); w.y = cvt_pk_bf16(o[2], o[3]);
                        if (bad) { w.x = 0x7fc07fc0u; w.y = 0x7fc07fc0u; } *(u32x2v*)(xn + off + bj * HALF + n * 16) = w; }
                asm volatile("" ::: "memory"); }
    }
};

template <class Epi, class Sched, bool ALIGN_EPI = false, bool SP2 = false>
__device__ __forceinline__ void gemm_phase(PG8_LAS unsigned char* lds, const Gemm g, const Sched& S, const Epi& E, const int tid) {
    const int wid = __builtin_amdgcn_readfirstlane(tid >> 6), lane = tid & 63, wr = wid >> 2, wc = wid & 3, fr = lane & 15, fq = lane >> 4;
    const int K = g.K, nt = K / BK;
    unsigned voffA[2], voffB[2];
#pragma unroll
    for (int i = 0; i < 2; ++i) { int R, C; stage_rc(tid * 16 + i * 8192, R, C); const int Rb = Epi::PERM ? ((R & ~31) + perm32(R & 31)) : R;
        voffA[i] = (unsigned)(R * g.lda + C) * 2u; voffB[i] = (unsigned)(Rb * K + C) * 2u; }
    const size_t kstep = (size_t)(BK * 2);
    const size_t hstep = (size_t)HALF * K * 2, hstepA = (size_t)HALF * g.lda * 2;
    const size_t tstep = 2 * hstep, tstepA = 2 * hstepA;
    const unsigned ldsw = (unsigned)wid * 1024u;
    const int aoff = lds_byte(wr * 64 + fr, fq * 8), boff = lds_byte(wc * 32 + fr, fq * 8);
#define PG8_SA(b, h) (((b) * 2 + (h)) * HTB)
#define PG8_SB(b, h) ((4 + (b) * 2 + (h)) * HTB)
#define PG8_STAGE(bufoff, gbase, voff) do { _Pragma("unroll") for (int _i = 0; _i < 2; ++_i) \
        __builtin_amdgcn_global_load_lds((const unsigned*)((const char*)(gbase) + (voff)[_i]), (PG8_LAS unsigned*)(lds + (bufoff) + ldsw + _i * 8192), 16, 0, 0); } while (0)
#define PG8_LDA(dst, b, h) do { _Pragma("unroll") for (int m = 0; m < 4; ++m) _Pragma("unroll") for (int k = 0; k < 2; ++k) dst[m][k] = *(const PG8_LAS bf16x8*)(lds + PG8_SA(b, h) + aoff + m * 2048 + k * 1024); } while (0)
#define PG8_LDB(dst, b, h) do { _Pragma("unroll") for (int n = 0; n < 2; ++n) _Pragma("unroll") for (int k = 0; k < 2; ++k) dst[n][k] = *(const PG8_LAS bf16x8*)(lds + PG8_SB(b, h) + boff + n * 2048 + k * 1024); } while (0)
#define PG8_MMA(ai, bj, At, Bt) do { __builtin_amdgcn_s_setprio(1); _Pragma("unroll") for (int m = 0; m < 4; ++m) _Pragma("unroll") for (int n = 0; n < 2; ++n) _Pragma("unroll") for (int k = 0; k < 2; ++k) \
        acc[ai][bj][m][n] = __builtin_amdgcn_mfma_f32_16x16x32_bf16(Bt[n][k], At[m][k], acc[ai][bj][m][n], 0, 0, 0); __builtin_amdgcn_s_setprio(0); } while (0)
#define PG8_WAIT_V(n) asm volatile("s_waitcnt vmcnt(" #n ")" ::: "memory")
#define PG8_WAIT_L(n) asm volatile("s_waitcnt lgkmcnt(" #n ")" ::: "memory")
#define PG8_BAR __builtin_amdgcn_s_barrier()
#define PG8_SCHED __builtin_amdgcn_sched_barrier(0)
    Unit cur, nxt; int ui = 0;
    if (!S.next(0, cur)) return;
    f32x4 acc[2][2][4][2];
#pragma unroll
    for (int a = 0; a < 2; ++a)
#pragma unroll
        for (int b = 0; b < 2; ++b)
#pragma unroll
            for (int m = 0; m < 4; ++m)
#pragma unroll
                for (int n = 0; n < 2; ++n) acc[a][b][m][n] = (f32x4){0.f, 0.f, 0.f, 0.f};
    bf16x8 At[4][2], B0[2][2], B1[2][2];
    const char* cA = (const char*)g.A + (size_t)cur.pm * tstepA; const char* cB = (const char*)g.Bt + (size_t)cur.pn * tstep;
    S.a_ready(cur);
    if constexpr (SP2) {
        PG8_STAGE(PG8_SB(0, 0), cB, voffB); PG8_STAGE(PG8_SB(0, 1), cB + hstep, voffB); PG8_STAGE(PG8_SA(0, 0), cA, voffA); PG8_STAGE(PG8_SA(0, 1), cA + hstepA, voffA);
        if (wr == 1) PG8_BAR;
        PG8_WAIT_V(2); PG8_BAR;
        PG8_STAGE(PG8_SB(1, 0), cB + kstep, voffB); PG8_STAGE(PG8_SA(1, 0), cA + kstep, voffA); PG8_STAGE(PG8_SB(1, 1), cB + hstep + kstep, voffB);
        PG8_WAIT_V(6); PG8_BAR;
    } else {
        PG8_STAGE(PG8_SB(0, 0), cB, voffB); PG8_STAGE(PG8_SA(0, 0), cA, voffA); PG8_STAGE(PG8_SB(0, 1), cB + hstep, voffB); PG8_STAGE(PG8_SA(0, 1), cA + hstepA, voffA);
        if (wr == 1) PG8_BAR;
        PG8_WAIT_V(4); PG8_BAR;
        PG8_STAGE(PG8_SB(1, 0), cB + kstep, voffB); PG8_STAGE(PG8_SA(1, 0), cA + kstep, voffA); PG8_STAGE(PG8_SB(1, 1), cB + hstep + kstep, voffB);
        PG8_WAIT_V(6); PG8_BAR;
    }
    for (;;) {
        const bool has_next = S.next(ui + 1, nxt);
        const char* nA = has_next ? (const char*)g.A + (size_t)nxt.pm * tstepA : cA; const char* nB = has_next ? (const char*)g.Bt + (size_t)nxt.pn * tstep : cB;
        for (int t = 0; t < nt; t += 2) {
            const bool last = (t == nt - 2);
            const char* a1 = cA + (size_t)(t + 1) * kstep;
            const char* a2 = last ? nA : cA + (size_t)(t + 2) * kstep; const char* b2 = last ? nB : cB + (size_t)(t + 2) * kstep;
            const char* a3 = a2 + kstep; const char* b3 = b2 + kstep;
            if (last && has_next) S.a_ready(nxt);
            if constexpr (SP2) {
            PG8_LDB(B0, 0, 0); PG8_LDB(B1, 0, 1); PG8_SCHED; PG8_LDA(At, 0, 0); PG8_STAGE(PG8_SA(1, 1), a1 + hstepA, voffA);
            PG8_WAIT_V(8); PG8_WAIT_L(0); PG8_BAR; PG8_MMA(0, 0, At, B0); PG8_MMA(0, 1, At, B1); PG8_BAR; PG8_SCHED;
            PG8_LDA(At, 0, 1); PG8_STAGE(PG8_SB(0, 0), b2, voffB); PG8_STAGE(PG8_SB(0, 1), b2 + hstep, voffB); PG8_STAGE(PG8_SA(0, 0), a2, voffA);
            PG8_WAIT_V(8); PG8_WAIT_L(0); PG8_BAR; PG8_MMA(1, 0, At, B0); PG8_MMA(1, 1, At, B1); PG8_BAR; PG8_SCHED;
            PG8_LDB(B0, 1, 0); PG8_LDB(B1, 1, 1); PG8_SCHED; PG8_LDA(At, 1, 0); PG8_STAGE(PG8_SA(0, 1), a2 + hstepA, voffA);
            PG8_WAIT_V(8); PG8_WAIT_L(0); PG8_BAR; PG8_MMA(0, 0, At, B0); PG8_MMA(0, 1, At, B1); PG8_BAR; PG8_SCHED;
            PG8_LDA(At, 1, 1); PG8_STAGE(PG8_SB(1, 0), b3, voffB); PG8_STAGE(PG8_SB(1, 1), b3 + hstep, voffB); PG8_STAGE(PG8_SA(1, 0), a3, voffA);
            PG8_WAIT_V(8); PG8_WAIT_L(0); PG8_BAR; PG8_MMA(1, 0, At, B0); PG8_MMA(1, 1, At, B1); PG8_BAR; PG8_SCHED;
            } else {
            PG8_LDB(B0, 0, 0); PG8_SCHED; PG8_LDA(At, 0, 0); PG8_STAGE(PG8_SA(1, 1), a1 + hstepA, voffA);
            PG8_WAIT_L(8); PG8_BAR; PG8_WAIT_L(0); PG8_MMA(0, 0, At, B0); PG8_BAR; PG8_SCHED;
            PG8_LDB(B1, 0, 1); PG8_STAGE(PG8_SB(0, 0), b2, voffB);
            PG8_BAR; PG8_WAIT_L(0); PG8_MMA(0, 1, At, B1); PG8_BAR;
            PG8_LDA(At, 0, 1); PG8_STAGE(PG8_SA(0, 0), a2, voffA);
            PG8_BAR; PG8_WAIT_L(0); PG8_MMA(1, 0, At, B0); PG8_BAR; PG8_SCHED;
            PG8_STAGE(PG8_SB(0, 1), b2 + hstep, voffB);
            PG8_WAIT_V(6); PG8_BAR; PG8_MMA(1, 1, At, B1); PG8_BAR;
            PG8_LDB(B0, 1, 0); PG8_SCHED; PG8_LDA(At, 1, 0); PG8_STAGE(PG8_SA(0, 1), a2 + hstepA, voffA);
            PG8_WAIT_L(8); PG8_BAR; PG8_WAIT_L(0); PG8_MMA(0, 0, At, B0); PG8_BAR; PG8_SCHED;
            PG8_LDB(B1, 1, 1); PG8_STAGE(PG8_SB(1, 0), b3, voffB);
            PG8_BAR; PG8_WAIT_L(0); PG8_MMA(0, 1, At, B1); PG8_BAR;
            PG8_LDA(At, 1, 1); PG8_STAGE(PG8_SA(1, 0), a3, voffA);
            PG8_BAR; PG8_WAIT_L(0); PG8_MMA(1, 0, At, B0); PG8_BAR; PG8_SCHED;
            PG8_STAGE(PG8_SB(1, 1), b3 + hstep, voffB);
            PG8_WAIT_V(6); PG8_BAR; PG8_MMA(1, 1, At, B1); PG8_BAR;
            }
        }
        if constexpr (ALIGN_EPI) { if (wr == 0) PG8_BAR; }
        if constexpr (!Epi::AFTER_DRAIN) { E(acc, cur, wr, wc, fr, fq); S.done(cur); }
        if (!has_next) break;
#pragma unroll
        for (int a = 0; a < 2; ++a)
#pragma unroll
            for (int b = 0; b < 2; ++b)
#pragma unroll
                for (int m = 0; m < 4; ++m)
#pragma unroll
                    for (int n = 0; n < 2; ++n) acc[a][b][m][n] = (f32x4){0.f, 0.f, 0.f, 0.f};
        cur = nxt; cA = nA; cB = nB; ++ui;
        if constexpr (ALIGN_EPI) { if (wr == 1) PG8_BAR; }
    }
    PG8_WAIT_V(0);
    if constexpr (!ALIGN_EPI) { if (wr == 0) PG8_BAR; }
    PG8_BAR;
    if constexpr (Epi::AFTER_DRAIN) { E.fused(acc, cur, wr, wc, fr, fq, lds, wid, lane); S.done(cur); }
#undef PG8_SA
#undef PG8_SB
#undef PG8_STAGE
#undef PG8_LDA
#undef PG8_LDB
#undef PG8_MMA
#undef PG8_WAIT_V
#undef PG8_WAIT_L
#undef PG8_BAR
#undef PG8_SCHED
}
}

#define GAS __attribute__((address_space(1)))
#define LAS __attribute__((address_space(3)))
typedef unsigned short bf16;
typedef unsigned v4u __attribute__((ext_vector_type(4)));
typedef unsigned v2u __attribute__((ext_vector_type(2)));
typedef float f32x4 __attribute__((ext_vector_type(4)));
typedef short bf16x8 __attribute__((ext_vector_type(8)));
#define RLX_AGENT __ATOMIC_RELAXED, __HIP_MEMORY_SCOPE_AGENT
#define LDS_WAIT() asm volatile("s_waitcnt lgkmcnt(0)" ::: "memory")
#define VM_WAIT() asm volatile("s_waitcnt vmcnt(0)" ::: "memory")

#ifndef MK_ONE_LAUNCH
#define MK_ONE_LAUNCH 0
#endif
#ifndef PROBE
#define PROBE 0
#endif

constexpr int T = 32768, SEQ = 16384, DM = 1024, DEPTH = 2;
constexpr int DIN = 7184;
constexpr int PW = 4352;
constexpr int C_RGX = 0, C_GQ = 512, C_GK = 768, C_GV = 1024, C_GG = 1536, C_HQ = 2048, C_HF = 2560, C_HI = 3072, C_HG = 3584, C_GA = 4096;
constexpr int DFF = 2816, DFFE = 3584, NEXP = 8;
constexpr float ALPHA = 1.4142135623730951f;
constexpr float LN_EPS = 1e-5f, RMS_EPS = 1e-6f;
constexpr int NWAVES = 8, NTHR = 512;
constexpr int MOE_CHUNK_PANELS = 64, MOE_NCHUNK = 5, MOE_MAXP = 320;

constexpr size_t MiB = 1u << 20;
constexpr size_t WS_CTL = 0, CTL_ZERO_BYTES = 1 * MiB;
constexpr size_t WS_SMALL = 1 * MiB;
constexpr size_t WS_TOKOF = 2 * MiB, WS_WOF = 3 * MiB;
constexpr size_t WS_WINA = 4 * MiB;
constexpr size_t WS_WGATE = 21 * MiB;
constexpr size_t WS_WBR = 33 * MiB;
constexpr size_t WS_WOUT = 39 * MiB;
constexpr size_t WS_WGU = 43 * MiB;
constexpr size_t WS_WD = 54 * MiB;
constexpr size_t WS_XB = 60 * MiB;
constexpr size_t WS_PROJ = 124 * MiB;
constexpr size_t WS_TEMPS = 396 * MiB;
constexpr size_t WS_RGA = 396 * MiB, WS_RGB = 460 * MiB;
constexpr size_t WS_G0 = 396 * MiB, WS_G1 = 460 * MiB;
constexpr size_t WS_X1B = 476 * MiB;
constexpr size_t WS_END = 540 * MiB;
constexpr size_t WS_MWGU = 4 * MiB;
constexpr size_t WS_MWD = 116 * MiB;
constexpr size_t WS_HC = 172 * MiB;
constexpr size_t WS_XS = 284 * MiB;
constexpr size_t WS_ENT = 316 * MiB;
constexpr size_t WS_YS0 = 320 * MiB, WS_YS1 = 384 * MiB;
static_assert(WS_YS1 + 64 * MiB <= WS_X1B, "moe overlay");

constexpr int CW_TMO = 0, CW_CODE = 1;
constexpr int CW_MOECNT = 64;
constexpr int CW_BAR = 4096;

constexpr int RING_BYTES = 131072;
constexpr int MISC_OFF = RING_BYTES;
constexpr int MOETAB_OFF = RING_BYTES + 1024;
constexpr int LDS_BYTES = 147456;

__device__ __forceinline__ unsigned f2bf(float f) { unsigned u = __builtin_bit_cast(unsigned, f); return (u + 0x7fffu + ((u >> 16) & 1u)) >> 16; }
__device__ __forceinline__ unsigned pk2(float lo, float hi) { return f2bf(lo) | (f2bf(hi) << 16); }
__device__ __forceinline__ float bf2f(bf16 b) { return __builtin_bit_cast(float, ((unsigned)b) << 16); }
__device__ __forceinline__ float bflo(unsigned w) { return __builtin_bit_cast(float, w << 16); }
__device__ __forceinline__ float bfhi(unsigned w) { return __builtin_bit_cast(float, w & 0xffff0000u); }
__device__ __forceinline__ float sigmoidf_(float x) { return 1.0f / (1.0f + __expf(-x)); }
__device__ __forceinline__ float wave_sum(float v) {
#pragma unroll
    for (int o = 1; o < 64; o <<= 1) v += __shfl_xor(v, o);
    return v;
}

#define XB_TMO      128
#define XB_XCNT(j)  (256  + 64 * (j))
#define XB_XSUB(j)  (1280 + 64 * (j))
#define XB_XGEN(j)  (2304 + 64 * (j))
#define XB_TOP      3328
#define XB_TOPGEN   3392
#define XCD_BAR_WORDS 3456
#define XB_SPIN_CAP (1u << 22)
__device__ __forceinline__ unsigned xb_ld(unsigned* p)              { return __hip_atomic_load(p, __ATOMIC_RELAXED, __HIP_MEMORY_SCOPE_AGENT); }
__device__ __forceinline__ unsigned xb_add(unsigned* p, unsigned v) { return __hip_atomic_fetch_add(p, v, __ATOMIC_RELAXED, __HIP_MEMORY_SCOPE_AGENT); }
__device__ __forceinline__ unsigned xb_xcc_id() { return (unsigned)__builtin_amdgcn_s_getreg((3 << 11) | 20) & 0xFu; }
#define XB_SPIN(cond, bar) do { unsigned _sp = 0; while (cond) { __builtin_amdgcn_s_sleep(1); \
    if ((++_sp & 255u) == 0u) { if (xb_ld(&(bar)[XB_TMO])) break; if (_sp > XB_SPIN_CAP) { atomicAdd(&(bar)[XB_TMO], 1u); break; } } } } while (0)
struct XcdBarrier { unsigned* bar; unsigned x; volatile LAS unsigned* st; };
__device__ __forceinline__ XcdBarrier xcd_barrier_post(unsigned* bar, volatile LAS unsigned* st) {
    XcdBarrier b; b.bar = bar; b.x = xb_xcc_id(); b.st = st;
    if (threadIdx.x == 0) (void)xb_add(&bar[XB_XCNT(b.x)], 1u);
    return b;
}
__device__ __forceinline__ void xcd_barrier_complete(unsigned* bar, unsigned x, unsigned& nloc, unsigned& nx) {
    const unsigned G = gridDim.x * gridDim.y * gridDim.z;
    unsigned sum, cnt, mine, sp = 0u;
    for (;;) {
        sum = 0u; cnt = 0u; mine = 0u;
#pragma unroll
        for (unsigned j = 0; j < 16; ++j) { const unsigned c = xb_ld(&bar[XB_XCNT(j)]); sum += c; cnt += (c > 0u) ? 1u : 0u; mine = (j == x) ? c : mine; }
        if (sum == G) break;
        __builtin_amdgcn_s_sleep(1);
        if ((++sp & 255u) == 0u) { if (xb_ld(&bar[XB_TMO])) break; if (sp > XB_SPIN_CAP) { atomicAdd(&bar[XB_TMO], 1u); break; } }
    }
    nloc = mine > 0u ? mine : 1u; nx = cnt > 0u ? cnt : 1u;
}
__device__ __forceinline__ void xcd_barrier(const XcdBarrier& b) {
    asm volatile("s_waitcnt vmcnt(0)" ::: "memory");
    __syncthreads();
    if (threadIdx.x == 0) {
        unsigned* bar = b.bar;
        __builtin_amdgcn_s_waitcnt(0);
        unsigned nloc = b.st[0], nx = b.st[1];
        if (nloc == 0u) { xcd_barrier_complete(bar, b.x, nloc, nx); b.st[0] = nloc; b.st[1] = nx; }
        const unsigned old = xb_add(&bar[XB_XSUB(b.x)], 1u);
        const unsigned gen = old / nloc;
        if (old + 1u == (gen + 1u) * nloc) {
            __builtin_amdgcn_fence(__ATOMIC_RELEASE, "agent");
            asm volatile("s_waitcnt vmcnt(0)" ::: "memory");
            const unsigned og = xb_add(&bar[XB_TOP], 1u);
            const unsigned tg = og / nx;
            if (og + 1u == (tg + 1u) * nx) xb_add(&bar[XB_TOPGEN], 1u);
            else XB_SPIN(xb_ld(&bar[XB_TOPGEN]) == tg, bar);
            __builtin_amdgcn_fence(__ATOMIC_ACQUIRE, "agent");
            xb_add(&bar[XB_XGEN(b.x)], 1u);
            asm volatile("s_waitcnt vmcnt(0)" ::: "memory");
        } else {
            XB_SPIN(xb_ld(&bar[XB_XGEN(b.x)]) == gen, bar);
            __builtin_amdgcn_fence(__ATOMIC_ACQUIRE, "agent");
            asm volatile("s_waitcnt vmcnt(0)" ::: "memory");
        }
    }
    __syncthreads();
}

struct Args { const float* in[27]; float* out; unsigned char* ws; int ph_lo, ph_hi; };
struct Ctx {
    LAS unsigned char* lds;
    unsigned* ctl;
    int tid, lane, wave, cu, G;
    const float* const* in;
    float* R;
    unsigned char* ws;
};
enum { I_X = 0, I_WIN, I_CONVW, I_CONVB, I_RGWR, I_RGBR, I_RGWI, I_RGBI, I_RGLAM, I_GLAWA, I_GLABA, I_GLANW, I_HGLB, I_HGNW, I_WBR, I_WOUT,
       I_LN1G, I_LN1B, I_LN2G, I_LN2B, I_FFNWG, I_FFNWU, I_FFNWD, I_ROUTER, I_MOEWG, I_MOEWU, I_MOEWD };

template <class Map>
__device__ __forceinline__ void tr_item(const float* W, int N, LAS float* scr, int kb, int nb, int lane, Map map) {
    const int k0 = 64 * kb, n0 = 32 * nb;
    const int cc = n0 + (lane & 31);
#pragma unroll 8
    for (int i = 0; i < 32; ++i) { const int kk = 2 * i + (lane >> 5); scr[kk * 33 + (lane & 31)] = (cc < N) ? W[(size_t)(k0 + kk) * N + cc] : 0.f; }
    LDS_WAIT(); asm volatile("" ::: "memory");
    const int c = lane & 7;
#pragma unroll
    for (int j = 0; j < 4; ++j) { const int n = (lane >> 3) + 8 * j; const LAS float* s = scr + (8 * c) * 33 + n;
        if (n0 + n < N) { bf16* dst = map(n0 + n);
            if (dst) { v4u o; o.x = pk2(s[0 * 33], s[1 * 33]); o.y = pk2(s[2 * 33], s[3 * 33]); o.z = pk2(s[4 * 33], s[5 * 33]); o.w = pk2(s[6 * 33], s[7 * 33]);
                *(v4u*)(dst + k0 + 8 * c) = o; } } }
    LDS_WAIT(); asm volatile("" ::: "memory");
}

__device__ __forceinline__ void phase_conv(Ctx& C) {
    LAS float* scr = (LAS float*)(C.lds + C.wave * 16384);
    const int gw = C.cu * NWAVES + C.wave, NGW = C.G * NWAVES;
    bf16* WINA = (bf16*)(C.ws + WS_WINA); bf16* WGATE = (bf16*)(C.ws + WS_WGATE); bf16* WBR = (bf16*)(C.ws + WS_WBR);
    bf16* WOUT = (bf16*)(C.ws + WS_WOUT); bf16* WGU = (bf16*)(C.ws + WS_WGU); bf16* WD = (bf16*)(C.ws + WS_WD);
    constexpr int I_IN = 16 * 225, I_BR = 8 * 32, I_OUT = 16 * 32, I_GU = 16 * 88, I_D = 44 * 32;
    constexpr int NIT = 2 * I_IN + 6 * I_BR + 2 * I_OUT + 2 * I_GU + I_D;
    for (int it = gw; it < NIT; it += NGW) {
        int r = it;
        if (r < 2 * I_IN) { const int l = r / I_IN; r -= l * I_IN; const int kb = r / 225, nb = r % 225;
            bf16* a = WINA + (size_t)l * PW * DM; bf16* g = WGATE + (size_t)l * 3072 * DM;
            tr_item(C.in[I_WIN] + (size_t)l * DM * DIN, DIN, scr, kb, nb, C.lane, [=](int c) -> bf16* {
                int d; if (c < 1536) d = c; else if (c < 1552) d = C_GA + (c - 1536); else if (c < 2064) d = C_GG + (c - 1552); else if (c < 4112) d = C_HQ + (c - 2064); else return g + (size_t)(c - 4112) * DM;
                return a + (size_t)d * DM; });
            continue; }
        r -= 2 * I_IN;
        if (r < 6 * I_BR) { const int m = r / I_BR; r -= m * I_BR; const int kb = r / 32, nb = r % 32; bf16* d = WBR + (size_t)m * 1024 * 512;
            tr_item(C.in[I_WBR] + (size_t)m * 512 * 1024, 1024, scr, kb, nb, C.lane, [=](int c) -> bf16* { return d + (size_t)c * 512; }); continue; }
        r -= 6 * I_BR;
        if (r < 2 * I_OUT) { const int l = r / I_OUT; r -= l * I_OUT; const int kb = r / 32, nb = r % 32; bf16* d = WOUT + (size_t)l * 1024 * 1024;
            tr_item(C.in[I_WOUT] + (size_t)l * 1024 * 1024, 1024, scr, kb, nb, C.lane, [=](int c) -> bf16* { return d + (size_t)c * 1024; }); continue; }
        r -= 2 * I_OUT;
        if (r < 2 * I_GU) { const int u = r / I_GU; r -= u * I_GU; const int kb = r / 88, nb = r % 88;
            tr_item(u ? C.in[I_FFNWU] : C.in[I_FFNWG], DFF, scr, kb, nb, C.lane, [=](int c) -> bf16* { return WGU + (size_t)((c >> 7) * 256 + u * 128 + (c & 127)) * 1024; }); continue; }
        r -= 2 * I_GU;
        { const int kb = r / 32, nb = r % 32; tr_item(C.in[I_FFNWD], 1024, scr, kb, nb, C.lane, [=](int c) -> bf16* { return WD + (size_t)c * DFF; }); }
    }
    for (int i = gw * 64 + C.lane; i < 2 * 240 * (DM / 8); i += NGW * 64) { const int l = i / (240 * 128), rr = (i / 128) % 240, ch = i % 128;
        *(v4u*)(WINA + ((size_t)l * PW + 4112 + rr) * DM + ch * 8) = (v4u){0u, 0u, 0u, 0u}; }
    const f32x4* x4 = (const f32x4*)C.in[I_X]; v4u* xb = (v4u*)(C.ws + WS_XB);
    for (size_t i = (size_t)gw * 64 + C.lane; i < (size_t)T * DM / 8; i += (size_t)NGW * 64) { const f32x4 a = x4[2 * i], b = x4[2 * i + 1];
        v4u o; o.x = pk2(a[0], a[1]); o.y = pk2(a[2], a[3]); o.z = pk2(b[0], b[1]); o.w = pk2(b[2], b[3]); xb[i] = o; }
}

__device__ __forceinline__ void phase_conv_moe(Ctx& C) {
    LAS float* scr = (LAS float*)(C.lds + C.wave * 16384);
    const int gw = C.cu * NWAVES + C.wave, NGW = C.G * NWAVES;
    bf16* MWGU = (bf16*)(C.ws + WS_MWGU); bf16* MWD = (bf16*)(C.ws + WS_MWD);
    constexpr int I_G = 16 * 112, I_D = 56 * 32;
    constexpr int NIT = NEXP * (2 * I_G + I_D);
    for (int it = gw; it < NIT; it += NGW) {
        const int e = it / (2 * I_G + I_D); int r = it % (2 * I_G + I_D);
        if (r < 2 * I_G) { const int u = r / I_G; r -= u * I_G; const int kb = r / 112, nb = r % 112; bf16* d = MWGU + (size_t)e * 7168 * 1024;
            tr_item((u ? C.in[I_MOEWU] : C.in[I_MOEWG]) + (size_t)e * 1024 * DFFE, DFFE, scr, kb, nb, C.lane, [=](int c) -> bf16* { return d + (size_t)((c >> 7) * 256 + u * 128 + (c & 127)) * 1024; }); continue; }
        r -= 2 * I_G;
        { const int kb = r / 32, nb = r % 32; bf16* d = MWD + (size_t)e * 1024 * DFFE;
          tr_item(C.in[I_MOEWD] + (size_t)e * DFFE * 1024, 1024, scr, kb, nb, C.lane, [=](int c) -> bf16* { return d + (size_t)c * DFFE; }); }
    }
}

template <bool MOE>
__device__ __forceinline__ void phase_ln(Ctx& C, const float* gam, const float* bet, bf16* xb_out) {
    const int gw = C.cu * NWAVES + C.wave, NGW = C.G * NWAVES;
    const bf16* ys0 = (const bf16*)(C.ws + WS_YS0); const bf16* ys1 = (const bf16*)(C.ws + WS_YS1);
    for (int m = gw; m < T; m += NGW) {
        f32x4* xr = (f32x4*)(C.R + (size_t)m * DM) + C.lane;
        f32x4 v[4]; float s = 0.f;
#pragma unroll
        for (int j = 0; j < 4; ++j) { v[j] = xr[64 * j];
            if (MOE) { const v2u a = *((const v2u*)(ys0 + (size_t)m * DM) + C.lane + 64 * j), b = *((const v2u*)(ys1 + (size_t)m * DM) + C.lane + 64 * j);
                v[j] = v[j] * ALPHA; v[j][0] += bflo(a.x) + bflo(b.x); v[j][1] += bfhi(a.x) + bfhi(b.x); v[j][2] += bflo(a.y) + bflo(b.y); v[j][3] += bfhi(a.y) + bfhi(b.y); }
            s += (v[j][0] + v[j][1]) + (v[j][2] + v[j][3]); }
        const float mean = wave_sum(s) * (1.f / DM); float s2 = 0.f;
#pragma unroll
        for (int j = 0; j < 4; ++j) { v[j] = v[j] - mean; s2 += (v[j][0] * v[j][0] + v[j][1] * v[j][1]) + (v[j][2] * v[j][2] + v[j][3] * v[j][3]); }
        const float rstd = 1.f / sqrtf(wave_sum(s2) * (1.f / DM) + LN_EPS);
#pragma unroll
        for (int j = 0; j < 4; ++j) { const f32x4 g4 = ((const f32x4*)gam)[C.lane + 64 * j], b4 = ((const f32x4*)bet)[C.lane + 64 * j];
            const f32x4 y = v[j] * rstd * g4 + b4; xr[64 * j] = y;
            if (xb_out) { v2u o; o.x = pk2(y[0], y[1]); o.y = pk2(y[2], y[3]); *((v2u*)(xb_out + (size_t)m * DM) + C.lane + 64 * j) = o; } }
    }
}

namespace pg8 {
struct EpiSig {
    static constexpr bool PERM = true, AFTER_DRAIN = false;
    bf16_t* O; int ldc;
    __device__ __forceinline__ void operator()(const f32x4 (&acc)[2][2][4][2], const Unit& u, int wr, int wc, int fr, int fq) const {
        const int row0 = u.pm * BM + wr * 64 + fr, col0 = u.pn * BM + wc * 32 + 8 * fq;
#pragma unroll
        for (int ai = 0; ai < 2; ++ai)
#pragma unroll
            for (int m = 0; m < 4; ++m) { bf16_t* rowp = O + (size_t)(row0 + ai * HALF + m * 16) * ldc + col0;
#pragma unroll
                for (int bj = 0; bj < 2; ++bj) { f32x4 v0 = acc[ai][bj][m][0], v1 = acc[ai][bj][m][1];
#pragma unroll
                    for (int j = 0; j < 4; ++j) { v0[j] = __builtin_amdgcn_rcpf(1.0f + __expf(-v0[j])); v1[j] = __builtin_amdgcn_rcpf(1.0f + __expf(-v1[j])); }
                    u32x4 w; w.x = cvt_pk_bf16(v0[0], v0[1]); w.y = cvt_pk_bf16(v0[2], v0[3]); w.z = cvt_pk_bf16(v1[0], v1[1]); w.w = cvt_pk_bf16(v1[2], v1[3]);
                    *(u32x4*)(rowp + bj * HALF) = w; } }
    }
};
struct EpiBranch {
    static constexpr bool PERM = true, AFTER_DRAIN = false;
    const bf16_t* G; int ldg; bf16_t* mixed; int first;
    __device__ __forceinline__ void operator()(const f32x4 (&acc)[2][2][4][2], const Unit& u, int wr, int wc, int fr, int fq) const {
        const int row0 = u.pm * BM + wr * 64 + fr, col0 = u.pn * BM + wc * 32 + 8 * fq;
#pragma unroll
        for (int ai = 0; ai < 2; ++ai)
#pragma unroll
            for (int m = 0; m < 4; ++m) { const size_t r = (size_t)(row0 + ai * HALF + m * 16);
#pragma unroll
                for (int bj = 0; bj < 2; ++bj) {
                    const u32x4 g = *(const u32x4*)(G + r * ldg + col0 + bj * HALF);
                    u32x4 p = (u32x4){0u, 0u, 0u, 0u}; if (!first) p = *(const u32x4*)(mixed + r * 1024 + col0 + bj * HALF);
                    const f32x4 v0 = acc[ai][bj][m][0], v1 = acc[ai][bj][m][1];
                    float o0 = __uint_as_float(p.x << 16) + __uint_as_float(g.x << 16) * v0[0], o1 = __uint_as_float(p.x & 0xffff0000u) + __uint_as_float(g.x & 0xffff0000u) * v0[1];
                    float o2 = __uint_as_float(p.y << 16) + __uint_as_float(g.y << 16) * v0[2], o3 = __uint_as_float(p.y & 0xffff0000u) + __uint_as_float(g.y & 0xffff0000u) * v0[3];
                    float o4 = __uint_as_float(p.z << 16) + __uint_as_float(g.z << 16) * v1[0], o5 = __uint_as_float(p.z & 0xffff0000u) + __uint_as_float(g.z & 0xffff0000u) * v1[1];
                    float o6 = __uint_as_float(p.w << 16) + __uint_as_float(g.w << 16) * v1[2], o7 = __uint_as_float(p.w & 0xffff0000u) + __uint_as_float(g.w & 0xffff0000u) * v1[3];
                    u32x4 w; w.x = cvt_pk_bf16(o0, o1); w.y = cvt_pk_bf16(o2, o3); w.z = cvt_pk_bf16(o4, o5); w.w = cvt_pk_bf16(o6, o7);
                    *(u32x4*)(mixed + r * 1024 + col0 + bj * HALF) = w; } }
    }
};
struct EpiResid {
    static constexpr bool PERM = false, AFTER_DRAIN = false;
    const float* base; float* out; float alpha;
    __device__ __forceinline__ void operator()(const f32x4 (&acc)[2][2][4][2], const Unit& u, int wr, int wc, int fr, int fq) const {
        const int row0 = u.pm * BM + wr * 64 + fr, col0 = u.pn * BM + wc * 32 + 4 * fq;
#pragma unroll
        for (int ai = 0; ai < 2; ++ai)
#pragma unroll
            for (int m = 0; m < 4; ++m) { const size_t off = (size_t)(row0 + ai * HALF + m * 16) * 1024 + col0;
#pragma unroll
                for (int bj = 0; bj < 2; ++bj)
#pragma unroll
                    for (int n = 0; n < 2; ++n) { const f32x4 bs = *(const f32x4*)(base + off + bj * HALF + n * 16); *(f32x4*)(out + off + bj * HALF + n * 16) = bs * alpha + acc[ai][bj][m][n]; } }
    }
};
struct EpiSwiGLU {
    static constexpr bool PERM = true, AFTER_DRAIN = false;
    bf16_t* H; int ldh;
    __device__ __forceinline__ void operator()(const f32x4 (&acc)[2][2][4][2], const Unit& u, int wr, int wc, int fr, int fq) const {
        const int row0 = u.pm * BM + wr * 64 + fr, col0 = u.aux * HALF + wc * 32 + 8 * fq;
#pragma unroll
        for (int ai = 0; ai < 2; ++ai)
#pragma unroll
            for (int m = 0; m < 4; ++m) { bf16_t* rowp = H + (size_t)(row0 + ai * HALF + m * 16) * ldh + col0;
                f32x4 h0, h1;
#pragma unroll
                for (int j = 0; j < 4; ++j) { const float g0 = acc[ai][0][m][0][j], g1 = acc[ai][0][m][1][j];
                    h0[j] = g0 * __builtin_amdgcn_rcpf(1.0f + __expf(-g0)) * acc[ai][1][m][0][j]; h1[j] = g1 * __builtin_amdgcn_rcpf(1.0f + __expf(-g1)) * acc[ai][1][m][1][j]; }
                u32x4 w; w.x = cvt_pk_bf16(h0[0], h0[1]); w.y = cvt_pk_bf16(h0[2], h0[3]); w.z = cvt_pk_bf16(h1[0], h1[1]); w.w = cvt_pk_bf16(h1[2], h1[3]);
                *(u32x4*)rowp = w; }
    }
};
struct EpiMoeDown {
    static constexpr bool PERM = true, AFTER_DRAIN = false;
    const int* ent; const float* pw; bf16_t *YS0, *YS1;
    __device__ __forceinline__ void operator()(const f32x4 (&acc)[2][2][4][2], const Unit& u, int wr, int wc, int fr, int fq) const {
        const int row0 = u.pm * BM + wr * 64 + fr, col0 = (u.pn & 3) * BM + wc * 32 + 8 * fq;
#pragma unroll
        for (int ai = 0; ai < 2; ++ai)
#pragma unroll
            for (int m = 0; m < 4; ++m) { const int r = row0 + ai * HALF + m * 16; const int en = ent[r]; const float p = pw[r];
                if (en >= 0) { bf16_t* rowp = ((en & 1) ? YS1 : YS0) + (size_t)(en >> 1) * 1024 + col0;
#pragma unroll
                    for (int bj = 0; bj < 2; ++bj) { const f32x4 v0 = acc[ai][bj][m][0] * p, v1 = acc[ai][bj][m][1] * p;
                        u32x4 w; w.x = cvt_pk_bf16(v0[0], v0[1]); w.y = cvt_pk_bf16(v0[2], v0[3]); w.z = cvt_pk_bf16(v1[0], v1[1]); w.w = cvt_pk_bf16(v1[2], v1[3]);
                        *(u32x4*)(rowp + bj * HALF) = w; } } }
    }
};
struct MoeOrder {
    const PG8_LAS int* pe; int pbase, np, G, c, nt, bt;
    __device__ __forceinline__ bool next(int i, Unit& u) const {
        const int L = i * G + c; if (L >= np * nt) return false;
        const int pl = L / nt, pn = L - pl * nt; const int e = pe[pbase + pl];
        u.pm = pl; u.pn = e * bt + pn; u.aux = pn; return true;
    }
    __device__ __forceinline__ void a_ready(const Unit&) const {}
    __device__ __forceinline__ void done(const Unit&) const {}
};
}

template <int K, bool GLA>
__device__ __forceinline__ void mix_naive(Ctx& C, int l, int b) {
    constexpr int TB = 8;
    LAS float* dec = (LAS float*)C.lds;
    LAS float* kk = dec + TB * 4 * K;
    LAS float* qq = kk + TB * 4 * K;
    LAS float* ob = qq + TB * 4 * K;
    LAS float* part = ob + TB * 512;
    const int tid = C.tid, h = tid >> 7, vc = tid & 127;
    float S[K];
#pragma unroll
    for (int k = 0; k < K; ++k) S[k] = 0.f;
    bf16* P = (bf16*)(C.ws + WS_PROJ) + (size_t)b * SEQ * PW;
    const float* wa = C.in[I_GLAWA] + (size_t)l * 16 * 256; const float* ba = C.in[I_GLABA] + l * 256;
    constexpr int VOFF = GLA ? C_GV : C_HI, GOFF = GLA ? C_GG : C_HG;
    for (int t0 = 0; t0 < SEQ; t0 += TB) {
        for (int idx = tid; idx < TB * 4 * K; idx += NTHR) {
            const int tt = idx / (4 * K), hk = idx % (4 * K);
            const bf16* row = P + (size_t)(t0 + tt) * PW;
            float d, kv, qv;
            if (GLA) {
                float z = ba[hk];
#pragma unroll
                for (int j = 0; j < 16; ++j) z += bf2f(row[C_GA + j]) * wa[j * 256 + hk];
                const float ls = fminf(z, 0.f) - log1pf(expf(-fabsf(z)));
                d = expf(ls * (1.f / 16.f)); kv = bf2f(row[C_GK + hk]); qv = bf2f(row[C_GQ + hk]) * 0.125f;
            } else {
                const float z = bf2f(row[C_HF + hk]);
                float lb = 0.f; if (l == 1) { const float x0 = C.in[I_HGLB][hk], x1 = C.in[I_HGLB][512 + hk]; lb = 1.f / (1.f + expf(x0 - x1)); }
                const float sg = 1.f / (1.f + expf(-z)); d = fmaxf(lb + (1.f - lb) * sg, 1e-30f); kv = (1.f - lb) / (1.f + expf(z));
                const float q = bf2f(row[C_HQ + hk]); qv = q / (1.f + expf(-q)) * 0.08838834764831845f;
            }
            dec[idx] = d; kk[idx] = kv; qq[idx] = qv;
        }
        __syncthreads();
        for (int tt = 0; tt < TB; ++tt) {
            const float v = bf2f(P[(size_t)(t0 + tt) * PW + VOFF + tid]); float acc = 0.f;
            const LAS f32x4* dp = (const LAS f32x4*)(dec + (tt * 4 + h) * K); const LAS f32x4* kp = (const LAS f32x4*)(kk + (tt * 4 + h) * K); const LAS f32x4* qp = (const LAS f32x4*)(qq + (tt * 4 + h) * K);
#pragma unroll
            for (int k4 = 0; k4 < K / 4; ++k4) { const f32x4 d4 = dp[k4], kv4 = kp[k4], q4 = qp[k4];
#pragma unroll
                for (int i = 0; i < 4; ++i) { S[4 * k4 + i] = S[4 * k4 + i] * d4[i] + kv4[i] * v; acc += S[4 * k4 + i] * q4[i]; } }
            ob[tt * 512 + tid] = acc;
        }
        __syncthreads();
        if (tid < TB * 4) { const LAS float* o = ob + (tid >> 2) * 512 + (tid & 3) * 128; float s = 0.f; for (int i = 0; i < 128; ++i) s += o[i] * o[i]; part[tid] = s; }
        __syncthreads();
        for (int tt = 0; tt < TB; ++tt) {
            bf16* row = P + (size_t)(t0 + tt) * PW; const float o = ob[tt * 512 + tid]; const float g = bf2f(row[GOFF + tid]); float y;
            if (GLA) { const float r = 1.f / sqrtf(part[tt * 4 + h] * (1.f / 128.f) + RMS_EPS); y = o * r * C.in[I_GLANW][l * 128 + vc] * (g / (1.f + expf(-g))); }
            else { const float r = 1.f / sqrtf((part[tt * 4] + part[tt * 4 + 1] + part[tt * 4 + 2] + part[tt * 4 + 3]) * (1.f / 512.f) + RMS_EPS); y = o * r * C.in[I_HGNW][l * 512 + tid] / (1.f + expf(-g)); }
            row[VOFF + tid] = (bf16)f2bf(y);
        }
        __syncthreads();
    }
}

__device__ __forceinline__ void rg_pass1_naive(Ctx& C, int l, int c0, int cstride) {
    LAS float* cs = (LAS float*)C.lds;
    const int ch = C.tid, g = ch >> 6, jj = ch & 63;
    const bf16* P = (const bf16*)(C.ws + WS_PROJ);
    float* Ao = (float*)(C.ws + WS_RGA); float* Bo = (float*)(C.ws + WS_RGB);
    const float cw0 = C.in[I_CONVW][(l * 4 + 0) * 512 + ch], cw1 = C.in[I_CONVW][(l * 4 + 1) * 512 + ch], cw2 = C.in[I_CONVW][(l * 4 + 2) * 512 + ch], cw3 = C.in[I_CONVW][(l * 4 + 3) * 512 + ch];
    const float cb = C.in[I_CONVB][l * 512 + ch], br = C.in[I_RGBR][l * 512 + ch], bi = C.in[I_RGBI][l * 512 + ch], lam = C.in[I_RGLAM][l * 512 + ch];
    const float xs = -lam, sp = fmaxf(xs, 0.f) + log1pf(expf(-fabsf(xs)));
    const float* wr = C.in[I_RGWR] + ((size_t)(l * 8 + g) * 64) * 64 + jj; const float* wi = C.in[I_RGWI] + ((size_t)(l * 8 + g) * 64) * 64 + jj;
    for (int it = c0; it < T / 8; it += cstride) {
        const int b = it / (SEQ / 8), t0 = (it % (SEQ / 8)) * 8;
        float u[11];
#pragma unroll
        for (int j = 0; j < 11; ++j) { const int tt = t0 - 3 + j; u[j] = tt >= 0 ? bf2f(P[((size_t)b * SEQ + tt) * PW + C_RGX + ch]) : 0.f; }
        float cv[8];
#pragma unroll
        for (int tt = 0; tt < 8; ++tt) { cv[tt] = cb + u[tt] * cw0 + u[tt + 1] * cw1 + u[tt + 2] * cw2 + u[tt + 3] * cw3; cs[tt * 512 + ch] = cv[tt]; }
        __syncthreads();
        float ar[8], ai[8];
#pragma unroll
        for (int tt = 0; tt < 8; ++tt) { ar[tt] = br; ai[tt] = bi; }
        for (int i = 0; i < 64; ++i) { const float w_r = wr[i * 64], w_i = wi[i * 64];
#pragma unroll
            for (int tt = 0; tt < 8; ++tt) { const float c = cs[tt * 512 + g * 64 + i]; ar[tt] += c * w_r; ai[tt] += c * w_i; } }
#pragma unroll
        for (int tt = 0; tt < 8; ++tt) { const float r = 1.f / (1.f + expf(-ar[tt])), ig = 1.f / (1.f + expf(-ai[tt]));
            const float la = -8.f * r * sp; const float a = expf(la); const float bb = sqrtf(fmaxf(-expm1f(2.f * la), 0.f)) * (ig * cv[tt]);
            const size_t o = ((size_t)b * SEQ + t0 + tt) * 512 + ch; Ao[o] = a; Bo[o] = bb; }
        __syncthreads();
    }
}
__device__ __forceinline__ void rg_pass2_naive(Ctx& C, int b) {
    const int ch = C.tid; bf16* P = (bf16*)(C.ws + WS_PROJ) + (size_t)b * SEQ * PW;
    const float* Ao = (const float*)(C.ws + WS_RGA) + (size_t)b * SEQ * 512; const float* Bo = (const float*)(C.ws + WS_RGB) + (size_t)b * SEQ * 512;
    float h = 0.f;
    for (int t = 0; t < SEQ; t += 8) { float a[8], bb[8];
#pragma unroll
        for (int j = 0; j < 8; ++j) { a[j] = Ao[(size_t)(t + j) * 512 + ch]; bb[j] = Bo[(size_t)(t + j) * 512 + ch]; }
#pragma unroll
        for (int j = 0; j < 8; ++j) { h = a[j] * h + bb[j]; P[(size_t)(t + j) * PW + C_RGX + ch] = (bf16)f2bf(h); } }
}

__device__ __forceinline__ void phase_router(Ctx& C) {
    LAS float* rw = (LAS float*)C.lds;
    LAS int* lcnt = (LAS int*)(C.lds + 32768);
    LAS int* lbase = lcnt + 8;
    LAS int* rec = lcnt + 16;
    LAS float* recp = (LAS float*)(rec + 512);
    unsigned* gcnt = C.ctl + CW_MOECNT;
    int* tokof = (int*)(C.ws + WS_TOKOF); float* wof = (float*)(C.ws + WS_WOF);
    for (int i = C.tid; i < 8192; i += NTHR) rw[i] = C.in[I_ROUTER][i];
    for (int grp = C.cu; grp < T / 128; grp += C.G) {
        if (C.tid < 8) lcnt[C.tid] = 0;
        __syncthreads();
        for (int q = 0; q < 16; ++q) {
            const int tl = C.wave * 16 + q, m = grp * 128 + tl;
            const f32x4* xr = (const f32x4*)(C.R + (size_t)m * DM) + C.lane;
            float lg[8];
#pragma unroll
            for (int e = 0; e < 8; ++e) lg[e] = 0.f;
#pragma unroll
            for (int j = 0; j < 4; ++j) { const f32x4 v = xr[64 * j];
#pragma unroll
                for (int i = 0; i < 4; ++i) { const int k = 4 * (C.lane + 64 * j) + i; const f32x4 w0 = *(const LAS f32x4*)(rw + k * 8), w1 = *(const LAS f32x4*)(rw + k * 8 + 4);
                    lg[0] += v[i] * w0[0]; lg[1] += v[i] * w0[1]; lg[2] += v[i] * w0[2]; lg[3] += v[i] * w0[3]; lg[4] += v[i] * w1[0]; lg[5] += v[i] * w1[1]; lg[6] += v[i] * w1[2]; lg[7] += v[i] * w1[3]; } }
#pragma unroll
            for (int e = 0; e < 8; ++e) lg[e] = wave_sum(lg[e]);
            if (C.lane == 0) {
                int e0 = 0; float l0 = lg[0];
#pragma unroll
                for (int e = 1; e < 8; ++e) if (lg[e] > l0) { l0 = lg[e]; e0 = e; }
                int e1 = -1; float l1 = -3.0e38f;
#pragma unroll
                for (int e = 0; e < 8; ++e) if (e != e0 && lg[e] > l1) { l1 = lg[e]; e1 = e; }
                const float p0 = 1.f / (1.f + expf(l1 - l0));
                const int pos0 = __hip_atomic_fetch_add(&lcnt[e0], 1, __ATOMIC_RELAXED, __HIP_MEMORY_SCOPE_WORKGROUP), pos1 = __hip_atomic_fetch_add(&lcnt[e1], 1, __ATOMIC_RELAXED, __HIP_MEMORY_SCOPE_WORKGROUP);
                rec[tl * 4 + 0] = e0; rec[tl * 4 + 1] = pos0; rec[tl * 4 + 2] = e1; rec[tl * 4 + 3] = pos1; recp[tl * 2] = p0; recp[tl * 2 + 1] = 1.f - p0;
            }
        }
        __syncthreads();
        if (C.tid < 8) lbase[C.tid] = (int)__hip_atomic_fetch_add(gcnt + C.tid, (unsigned)lcnt[C.tid], RLX_AGENT);
        __syncthreads();
        if (C.tid < 128) { const int m = grp * 128 + C.tid; const int e0 = rec[C.tid * 4], p0 = rec[C.tid * 4 + 1], e1 = rec[C.tid * 4 + 2], p1 = rec[C.tid * 4 + 3];
            tokof[e0 * T + lbase[e0] + p0] = m * 2; wof[e0 * T + lbase[e0] + p0] = recp[C.tid * 2];
            tokof[e1 * T + lbase[e1] + p1] = m * 2 + 1; wof[e1 * T + lbase[e1] + p1] = recp[C.tid * 2 + 1]; }
        __syncthreads();
    }
}
__device__ __forceinline__ int moe_build_table(Ctx& C) {
    LAS int* tab = (LAS int*)(C.lds + MOETAB_OFF);
    if (C.tid == 0) { int p = 0;
        for (int e = 0; e < 8; ++e) { const int c = (int)__hip_atomic_load(C.ctl + CW_MOECNT + e, RLX_AGENT); const int np = (c + 255) >> 8;
            for (int j = 0; j < np && p < MOE_MAXP; ++j, ++p) { tab[p] = e; tab[MOE_MAXP + p] = j * 256; } }
        tab[2 * MOE_MAXP] = p; }
    __syncthreads();
    return tab[2 * MOE_MAXP];
}
__device__ __forceinline__ void phase_moe_gather(Ctx& C, int chunk, int NP) {
    const LAS int* tab = (const LAS int*)(C.lds + MOETAB_OFF);
    const int gw = C.cu * NWAVES + C.wave, NGW = C.G * NWAVES;
    const int* tokof = (const int*)(C.ws + WS_TOKOF); const float* wof = (const float*)(C.ws + WS_WOF);
    const bf16* x3b = (const bf16*)(C.ws + WS_X1B); bf16* xs = (bf16*)(C.ws + WS_XS);
    int* ent = (int*)(C.ws + WS_ENT); float* pw = (float*)(C.ws + WS_ENT) + 16384;
    const int pbase = chunk * MOE_CHUNK_PANELS; int np = NP - pbase; if (np > MOE_CHUNK_PANELS) np = MOE_CHUNK_PANELS; if (np < 0) np = 0;
    for (int r = gw; r < np * 256; r += NGW) {
        const int p = pbase + (r >> 8), e = tab[p], pos = tab[MOE_MAXP + p] + (r & 255);
        const int cnt = (int)__hip_atomic_load(C.ctl + CW_MOECNT + e, RLX_AGENT);
        int en = -1; float w = 0.f; if (pos < cnt) { en = tokof[e * T + pos]; w = wof[e * T + pos]; }
        v4u a = (v4u){0u, 0u, 0u, 0u}, b2 = a;
        if (en >= 0) { const v4u* src = (const v4u*)(x3b + (size_t)(en >> 1) * DM); a = src[C.lane]; b2 = src[64 + C.lane]; }
        v4u* dst = (v4u*)(xs + (size_t)r * DM); dst[C.lane] = a; dst[64 + C.lane] = b2;
        if (C.lane == 0) { ent[r] = en; pw[r] = w; }
    }
}


#if PROBE
constexpr int CW_CHK = 128;
__device__ __forceinline__ float dot_bf_f32col(const bf16* a, const float* W, int N, int col, int K, int lane) {
    float s = 0.f; for (int k = lane; k < K; k += 64) s += bf2f(a[k]) * W[(size_t)k * N + col]; return wave_sum(s); }
__device__ __forceinline__ void chk_flag(Ctx& C, int bit, float got, float exp_, float atol, float rtol) {
    if (!(fabsf(got - exp_) <= atol + rtol * fabsf(exp_))) { if (C.lane == 0) atomicOr(C.ctl + CW_CHK, 1u << bit); } }
__device__ __forceinline__ unsigned hsh(unsigned x) { x ^= x >> 16; x *= 0x7feb352du; x ^= x >> 15; x *= 0x846ca68bu; x ^= x >> 16; return x; }
__device__ __forceinline__ void phase_chk(Ctx& C, int which, int l) {
    const int gw = C.cu * NWAVES + C.wave;
    const bf16* XB = (const bf16*)(C.ws + WS_XB); const bf16* PROJ = (const bf16*)(C.ws + WS_PROJ); const bf16* X1B = (const bf16*)(C.ws + WS_X1B);
    const bf16* G0 = (const bf16*)(C.ws + WS_G0); const bf16* G1 = (const bf16*)(C.ws + WS_G1);
    float* save = (float*)(C.ws + WS_SMALL);
    if (gw >= 256) return;
    const unsigned h = hsh(gw * 7919u + which * 104729u + l * 31u + 12345u);
    const int t = (gw & 1) ? (int)(h % T) : ((gw >> 1) * 256 + (int)(h % 256)) % T;
    if (which == 0) { const int c = (int)((h >> 8) % 4112);
        int oc; if (c < 1536) oc = c; else if (c < 2048) oc = 1552 + (c - 1536); else if (c < 4096) oc = 2064 + (c - 2048); else oc = 1536 + (c - 4096);
        const float e = dot_bf_f32col(XB + (size_t)t * DM, C.in[I_WIN] + (size_t)l * DM * DIN, DIN, oc, DM, C.lane);
        chk_flag(C, 0, bf2f(PROJ[(size_t)t * PW + c]), e, 0.03f, 0.02f); }
    else if (which == 1) { const int c = (int)((h >> 8) % 3072); const int n = c >> 10, d = c & 1023;
        const float e = dot_bf_f32col(XB + (size_t)t * DM, C.in[I_WIN] + (size_t)l * DM * DIN, DIN, 4112 + c, DM, C.lane);
        const float g = n == 0 ? bf2f(G0[(size_t)t * 1024 + d]) : (n == 1 ? bf2f(G1[(size_t)t * 1024 + d]) : bf2f(PROJ[(size_t)t * PW + C_HQ + d]));
        chk_flag(C, 1, g, 1.f / (1.f + expf(-e)), 0.01f, 0.01f); }
    else if (which == 2) { const int d = (int)((h >> 8) % 1024); float e = 0.f;
        for (int n = 0; n < 3; ++n) { const int ycol = n == 0 ? C_RGX : (n == 1 ? C_GV : C_HI);
            const float g = n == 0 ? bf2f(G0[(size_t)t * 1024 + d]) : (n == 1 ? bf2f(G1[(size_t)t * 1024 + d]) : bf2f(PROJ[(size_t)t * PW + C_HQ + d]));
            e += g * dot_bf_f32col(PROJ + (size_t)t * PW + ycol, C.in[I_WBR] + (size_t)(l * 3 + n) * 512 * 1024, 1024, d, 512, C.lane); }
        chk_flag(C, 2, bf2f(XB[(size_t)t * DM + d]), e, 0.02f, 0.03f); }
    else if (which == 3) { if (l == 0) { const int d = (int)((h >> 8) % 1024);
        const float e = ALPHA * C.in[I_X][(size_t)t * DM + d] + dot_bf_f32col(XB + (size_t)t * DM, C.in[I_WOUT] + (size_t)l * DM * DM, DM, d, DM, C.lane);
        chk_flag(C, 3, C.R[(size_t)t * DM + d], e, 0.02f, 0.01f); } }
    else if (which == 4) { const int j = (int)((h >> 8) % DFF); const int d = (int)((h >> 4) % 1024);
        const float g = dot_bf_f32col(X1B + (size_t)t * DM, C.in[I_FFNWG], DFF, j, DM, C.lane), u = dot_bf_f32col(X1B + (size_t)t * DM, C.in[I_FFNWU], DFF, j, DM, C.lane);
        chk_flag(C, 4, bf2f(PROJ[(size_t)t * DFF + j]), g / (1.f + expf(-g)) * u, 0.03f, 0.03f);
        if (C.lane == 0) save[gw] = C.R[(size_t)t * DM + d]; }
    else if (which == 5) { const unsigned h4 = hsh(gw * 7919u + 4 * 104729u + l * 31u + 12345u); const int t4 = (gw & 1) ? (int)(h4 % T) : ((gw >> 1) * 256 + (int)(h4 % 256)) % T; const int d = (int)((h4 >> 4) % 1024);
        const float e = ALPHA * save[gw] + dot_bf_f32col(PROJ + (size_t)t4 * DFF, C.in[I_FFNWD], DM, d, DFF, C.lane);
        chk_flag(C, 5, C.R[(size_t)t4 * DM + d], e, 0.02f, 0.01f); }
    else if (which == 6) { if (gw < 64) {
        const int tt = (int)(hsh(gw * 977u + 5u) % T); const int d0 = (int)(hsh(gw * 131u + 9u) % 1024);
        float lg[8];
#pragma unroll
        for (int e = 0; e < 8; ++e) { float s = 0.f; for (int k = C.lane; k < DM; k += 64) s += C.R[(size_t)tt * DM + k] * C.in[I_ROUTER][k * 8 + e]; lg[e] = wave_sum(s); }
        int e0 = 0; float l0 = lg[0];
#pragma unroll
        for (int e = 1; e < 8; ++e) if (lg[e] > l0) { l0 = lg[e]; e0 = e; }
        int e1 = -1; float l1 = -3.0e38f;
#pragma unroll
        for (int e = 0; e < 8; ++e) if (e != e0 && lg[e] > l1) { l1 = lg[e]; e1 = e; }
        const float p0 = 1.f / (1.f + expf(l1 - l0));
        float f = 0.f;
        for (int s = 0; s < 2; ++s) { const int e = s ? e1 : e0; const float p = s ? 1.f - p0 : p0;
            const float* wg = C.in[I_MOEWG] + (size_t)e * DM * DFFE; const float* wu = C.in[I_MOEWU] + (size_t)e * DM * DFFE; const float* wd = C.in[I_MOEWD] + (size_t)e * DFFE * DM;
            float acc = 0.f;
            for (int j = C.lane; j < DFFE; j += 64) { float g = 0.f, u = 0.f;
                for (int k = 0; k < DM; ++k) { const float xv = bf2f(X1B[(size_t)tt * DM + k]); g += xv * wg[(size_t)k * DFFE + j]; u += xv * wu[(size_t)k * DFFE + j]; }
                acc += (g / (1.f + expf(-g)) * u) * wd[(size_t)j * DM + d0]; }
            f += p * wave_sum(acc); }
        const bf16* ys0 = (const bf16*)(C.ws + WS_YS0); const bf16* ys1 = (const bf16*)(C.ws + WS_YS1);
        chk_flag(C, 6, bf2f(ys0[(size_t)tt * DM + d0]) + bf2f(ys1[(size_t)tt * DM + d0]), f, 0.02f, 0.04f); } }
}
__device__ __forceinline__ void phase_chk_encode(Ctx& C) {
    const unsigned code = __hip_atomic_load(C.ctl + CW_CHK, RLX_AGENT);
    if (code == 0u) return;
    const float c = sqrtf((float)code);
    for (size_t i = (size_t)C.cu * NTHR + C.tid; i < (size_t)T * DM; i += (size_t)C.G * NTHR) C.R[i] = c;
}
#endif
__global__ void __launch_bounds__(NTHR, 2) mega(Args args) {
    extern __shared__ __attribute__((aligned(16))) unsigned char lds_raw[];
    Ctx C;
    C.lds = (LAS unsigned char*)lds_raw;
    C.tid = threadIdx.x; C.lane = C.tid & 63; C.wave = __builtin_amdgcn_readfirstlane(C.tid >> 6);
    C.G = gridDim.x; C.cu = blockIdx.x;
    C.ws = args.ws; C.ctl = (unsigned*)(args.ws + WS_CTL); C.R = args.out;
    C.in = args.in;
    volatile LAS unsigned* MISC = (volatile LAS unsigned*)(C.lds + MISC_OFF);
    for (int u = C.tid; u < 64; u += NTHR) MISC[u] = 0u;
    __syncthreads();
#if MK_ONE_LAUNCH
    XcdBarrier bar = xcd_barrier_post(C.ctl + CW_BAR, MISC + 8);
#define SEAM() xcd_barrier(bar)
#else
#define SEAM() do { } while (0)
#endif
    const int lo = args.ph_lo, hi = args.ph_hi;
    int ph = 0;
#define IN_PH() (lo <= ph && ph < hi)
#ifndef PH_MASK
#define PH_MASK 0xffffffffu
#endif
#define EN(k) (((PH_MASK) >> (k)) & 1u)
#define PH_BEGIN() do { int _t = threadIdx.x; asm volatile("" : "+v"(_t)); C.tid = _t; C.lane = _t & 63; C.wave = __builtin_amdgcn_readfirstlane(_t >> 6); \
    unsigned char* _w = args.ws; asm volatile("" : "+s"(_w)); C.ws = _w; C.ctl = (unsigned*)(_w + WS_CTL); float* _r = args.out; asm volatile("" : "+s"(_r)); C.R = _r; } while (0)
#define NEXT_PH() do { if (lo <= ph && ph + 1 < hi) SEAM(); ++ph; } while (0)
    LAS unsigned char* ring = C.lds;
#define XB ((bf16*)(C.ws + WS_XB))
#define PROJ ((bf16*)(C.ws + WS_PROJ))
#define X1B ((bf16*)(C.ws + WS_X1B))
#define G0 ((bf16*)(C.ws + WS_G0))
#define G1 ((bf16*)(C.ws + WS_G1))

    if (IN_PH() && EN(0)) { PH_BEGIN(); phase_conv(C); }
    NEXT_PH();

    for (int l = 0; l < DEPTH; ++l) {
        if (IN_PH() && EN(1)) { PH_BEGIN(); pg8::Gemm g{XB, (const bf16*)(C.ws + WS_WINA) + (size_t)l * PW * DM, T, PW, DM, DM}; pg8::StaticOrder S; S.init(T, PW, C.G, C.cu);
            pg8::EpiBf16<0> E{PROJ, PW, nullptr, 0, 0, 1.f};
            pg8::gemm_phase<pg8::EpiBf16<0>, pg8::StaticOrder, true, true>(ring, g, S, E, C.tid); }
        NEXT_PH();
        #if PROBE
        if (IN_PH()) { PH_BEGIN(); phase_chk(C, 0, l); }
        NEXT_PH();
#endif
        if (IN_PH() && EN(2)) {   }
        NEXT_PH();
        if (IN_PH() && EN(3)) { PH_BEGIN(); if (C.cu < 2) rg_pass2_naive(C, C.cu); }
        NEXT_PH();
        if (IN_PH() && EN(4)) { PH_BEGIN();
            for (int n = 0; n < 3; ++n) {
                pg8::Gemm g{XB, (const bf16*)(C.ws + WS_WGATE) + ((size_t)l * 3072 + n * 1024) * DM, T, 1024, DM, DM}; pg8::StaticOrder S; S.init(T, 1024, C.G, C.cu);
                bf16* gp = G0 + (size_t)n * ((WS_G1 - WS_G0) / 2); int ldg = 1024; if (n == 2) { gp = PROJ + C_HQ; ldg = PW; }
                pg8::EpiSig E{gp, ldg};
                pg8::gemm_phase<pg8::EpiSig, pg8::StaticOrder, true, true>(ring, g, S, E, C.tid);
                __syncthreads();
            } }
        NEXT_PH();
        #if PROBE
        if (IN_PH()) { PH_BEGIN(); phase_chk(C, 1, l); }
        NEXT_PH();
#endif
        if (IN_PH() && EN(5)) { PH_BEGIN();
            for (int n = 0; n < 3; ++n) {
#ifdef ABL_SKIP_BRANCH
                if (n == ABL_SKIP_BRANCH) continue;
#endif
                const int ycol = n * 1024 + (n == 2 ? 1024 : 0);
                pg8::Gemm g{PROJ + ycol, (const bf16*)(C.ws + WS_WBR) + (size_t)(l * 3 + n) * 1024 * 512, T, 1024, 512, PW}; pg8::StaticOrder S; S.init(T, 1024, C.G, C.cu);
                #ifdef ABL_SKIP_BRANCH
                const int firstn = ABL_SKIP_BRANCH == 0 ? 1 : 0;
#else
                const int firstn = 0;
#endif
                const bf16* gp = G0 + (size_t)n * ((WS_G1 - WS_G0) / 2); int ldg = 1024; if (n == 2) { gp = PROJ + C_HQ; ldg = PW; }
                pg8::EpiBranch E{gp, ldg, XB, n == firstn ? 1 : 0};
                pg8::gemm_phase<pg8::EpiBranch, pg8::StaticOrder, true, true>(ring, g, S, E, C.tid);
                __syncthreads();
            }
        }
        NEXT_PH();
        #if PROBE
        if (IN_PH()) { PH_BEGIN(); phase_chk(C, 2, l); }
        NEXT_PH();
#endif
        if (IN_PH() && EN(6)) { PH_BEGIN(); pg8::Gemm g{XB, (const bf16*)(C.ws + WS_WOUT) + (size_t)l * 1024 * 1024, T, 1024, 1024, 1024}; pg8::StaticOrder S; S.init(T, 1024, C.G, C.cu);
            pg8::EpiResid E{l == 0 ? C.in[I_X] : C.R, C.R, ALPHA};
            pg8::gemm_phase<pg8::EpiResid, pg8::StaticOrder, true, true>(ring, g, S, E, C.tid); }
        NEXT_PH();
        #if PROBE
        if (IN_PH()) { PH_BEGIN(); phase_chk(C, 3, l); }
        NEXT_PH();
#endif
        if (IN_PH() && EN(7)) { PH_BEGIN(); phase_ln<false>(C, C.in[I_LN1G] + l * DM, C.in[I_LN1B] + l * DM, X1B); }
        NEXT_PH();
        if (l == 0) {
            if (IN_PH() && EN(8)) { PH_BEGIN(); pg8::Gemm g{X1B, (const bf16*)(C.ws + WS_WGU), T, 2 * DFF, DM, DM}; pg8::StaticOrder S; S.init(T, 2 * DFF, C.G, C.cu);
                pg8::EpiSwiGLU E{PROJ, DFF};
                pg8::gemm_phase<pg8::EpiSwiGLU, pg8::StaticOrder, true, true>(ring, g, S, E, C.tid); }
            NEXT_PH();
            #if PROBE
            if (IN_PH()) { PH_BEGIN(); phase_chk(C, 4, l); }
            NEXT_PH();
#endif
            if (IN_PH() && EN(9)) { PH_BEGIN(); pg8::Gemm g{PROJ, (const bf16*)(C.ws + WS_WD), T, 1024, DFF, DFF}; pg8::StaticOrder S; S.init(T, 1024, C.G, C.cu);
                pg8::EpiResid E{C.R, C.R, ALPHA};
                pg8::gemm_phase<pg8::EpiResid, pg8::StaticOrder, true, true>(ring, g, S, E, C.tid); }
            NEXT_PH();
            #if PROBE
            if (IN_PH()) { PH_BEGIN(); phase_chk(C, 5, l); }
            NEXT_PH();
#endif
            if (IN_PH() && EN(10)) { PH_BEGIN(); phase_ln<false>(C, C.in[I_LN2G], C.in[I_LN2B], XB); }
            NEXT_PH();
        } else {
            if (IN_PH() && EN(11)) { PH_BEGIN(); phase_router(C); __syncthreads(); phase_conv_moe(C); }
            NEXT_PH();
            for (int ck = 0; ck < MOE_NCHUNK; ++ck) {
                int NP = 0;
                if (IN_PH() && EN(12)) { PH_BEGIN(); NP = moe_build_table(C); phase_moe_gather(C, ck, NP); }
                NEXT_PH();
                if (IN_PH() && EN(13)) { PH_BEGIN(); NP = moe_build_table(C); int np = NP - ck * MOE_CHUNK_PANELS; if (np > MOE_CHUNK_PANELS) np = MOE_CHUNK_PANELS;
                    if (np > 0) { pg8::Gemm g{(const bf16*)(C.ws + WS_XS), (const bf16*)(C.ws + WS_MWGU), 16384, 7168, DM, DM};
                        pg8::MoeOrder S{(const LAS int*)(C.lds + MOETAB_OFF), ck * MOE_CHUNK_PANELS, np, C.G, C.cu, 28, 28};
                        pg8::EpiSwiGLU E{(bf16*)(C.ws + WS_HC), DFFE};
                        pg8::gemm_phase<pg8::EpiSwiGLU, pg8::MoeOrder, true, true>(ring, g, S, E, C.tid); } }
                NEXT_PH();
                if (IN_PH() && EN(14)) { PH_BEGIN(); NP = moe_build_table(C); int np = NP - ck * MOE_CHUNK_PANELS; if (np > MOE_CHUNK_PANELS) np = MOE_CHUNK_PANELS;
                    if (np > 0) { pg8::Gemm g{(const bf16*)(C.ws + WS_HC), (const bf16*)(C.ws + WS_MWD), 16384, 1024, DFFE, DFFE};
                        pg8::MoeOrder S{(const LAS int*)(C.lds + MOETAB_OFF), ck * MOE_CHUNK_PANELS, np, C.G, C.cu, 4, 4};
                        pg8::EpiMoeDown E{(const int*)(C.ws + WS_ENT), (const float*)(C.ws + WS_ENT) + 16384, (bf16*)(C.ws + WS_YS0), (bf16*)(C.ws + WS_YS1)};
                        pg8::gemm_phase<pg8::EpiMoeDown, pg8::MoeOrder, true, true>(ring, g, S, E, C.tid); } }
                NEXT_PH();
            }
            #if PROBE
            if (IN_PH()) { PH_BEGIN(); phase_chk(C, 6, l); }
            NEXT_PH();
#endif
            if (IN_PH() && EN(15)) { PH_BEGIN(); phase_ln<true>(C, C.in[I_LN2G] + DM, C.in[I_LN2B] + DM, nullptr); }
            NEXT_PH();
        }
    }
#if PROBE
    if (IN_PH()) { PH_BEGIN(); phase_chk_encode(C); }
    NEXT_PH();
#endif
}

__global__ void __launch_bounds__(NTHR, 2) mix1_naive_kernel(Args args, int l) {
    extern __shared__ __attribute__((aligned(16))) unsigned char lds_raw[];
    Ctx C; C.lds = (LAS unsigned char*)lds_raw; C.tid = threadIdx.x; C.lane = C.tid & 63; C.wave = __builtin_amdgcn_readfirstlane(C.tid >> 6);
    C.G = gridDim.x; C.cu = blockIdx.x; C.ws = args.ws; C.ctl = (unsigned*)(args.ws + WS_CTL); C.R = args.out; C.in = args.in;
    if (C.cu < 2) mix_naive<64, true>(C, l, C.cu);
    else if (C.cu < 4) mix_naive<128, false>(C, l, C.cu - 2);
    else rg_pass1_naive(C, l, C.cu - 4, C.G - 4);
}
#undef XB
#undef PROJ
#undef X1B
#undef G0
#undef G1
#if PROBE
constexpr int N_PHASES = 1 + (7 + 3) + (7 + 1 + 3 * MOE_NCHUNK + 1) + (4 + 2) + (4 + 1) + 1;
#else
constexpr int N_PHASES = 1 + (7 + 3) + (7 + 1 + 3 * MOE_NCHUNK + 1);
#endif

extern "C" void kernel_launch(void* const* d_in, const int* in_sizes, int n_in, void* d_out, int out_size, void* d_ws, size_t ws_size, hipStream_t stream) {
    static int grid = 0;
    if (grid == 0) {
        if (n_in != 27 || in_sizes[0] != T * DM || out_size != T * DM || ws_size < WS_END) { fprintf(stderr, "kernel_launch: unexpected shapes (n_in %d, in0 %d, out %d, ws %zu)\n", n_in, n_in > 0 ? in_sizes[0] : -1, out_size, ws_size); grid = -1; return; }
        int dev = 0, cus = 0;
        if (hipGetDevice(&dev) != hipSuccess || hipDeviceGetAttribute(&cus, hipDeviceAttributeMultiprocessorCount, dev) != hipSuccess) { grid = -1; return; }
        (void)hipFuncSetAttribute((const void*)mix1_naive_kernel, hipFuncAttributeMaxDynamicSharedMemorySize, LDS_BYTES);
        if (hipFuncSetAttribute((const void*)mega, hipFuncAttributeMaxDynamicSharedMemorySize, LDS_BYTES) != hipSuccess) { fprintf(stderr, "kernel_launch: hipFuncSetAttribute failed\n"); grid = -1; return; }
        int per_cu = 0;
        if (hipOccupancyMaxActiveBlocksPerMultiprocessor(&per_cu, (const void*)mega, NTHR, LDS_BYTES) != hipSuccess || per_cu < 1) fprintf(stderr, "kernel_launch: occupancy query says %d\n", per_cu);
        (void)hipGetLastError();
        grid = cus;
    }
    if (grid < 0) return;
    (void)hipMemsetAsync((char*)d_ws + WS_CTL, 0, CTL_ZERO_BYTES, stream);
    Args a{};
    for (int i = 0; i < 27; ++i) a.in[i] = (const float*)d_in[i];
    a.out = (float*)d_out; a.ws = (unsigned char*)d_ws;
#if MK_ONE_LAUNCH
    a.ph_lo = 0; a.ph_hi = N_PHASES;
    hipLaunchKernelGGL(mega, dim3(grid), dim3(NTHR), LDS_BYTES, stream, a);
#else
    const int mix1_l0 = 2 + (PROBE ? 1 : 0), mix1_l1 = mix1_l0 + 10 + (PROBE ? 6 : 0);
    for (int p = 0; p < N_PHASES; ++p) {
        if (p == mix1_l0 || p == mix1_l1) { hipLaunchKernelGGL(mix1_naive_kernel, dim3(grid), dim3(NTHR), LDS_BYTES, stream, a, p == mix1_l0 ? 0 : 1); continue; }
        a.ph_lo = p; a.ph_hi = p + 1; hipLaunchKernelGGL(mega, dim3(grid), dim3(NTHR), LDS_BYTES, stream, a); }
#endif
}
```

```cpp
#define MK_ONE_LAUNCH 1
#include <hip/hip_runtime.h>
#include <cstdio>
#include <cstdint>
namespace pg8 {
#define PG8_LAS __attribute__((address_space(3)))
typedef unsigned short bf16_t;
typedef short bf16x8 __attribute__((ext_vector_type(8)));
typedef float f32x4 __attribute__((ext_vector_type(4)));
typedef unsigned u32x4 __attribute__((ext_vector_type(4)));
constexpr int BM = 256, BK = 64, HALF = 128, HTB = HALF * BK * 2  , STAGE_BYTES = 8 * HTB, NXCD = 8, WGM = 8;

__host__ __device__ __forceinline__ int lds_byte(int r, int c) { const int st = (r >> 4) * 2 + (c >> 5), rr = r & 15, cc = c & 31, ob = rr * 64 + cc * 2; return st * 1024 + (ob ^ (((ob >> 9) & 1) << 5)); }
__host__ __device__ __forceinline__ void stage_rc(int b, int& R, int& C) { const int st = b / 1024, sb = b % 1024, swz = sb ^ (((sb >> 9) & 1) << 5); R = (st >> 1) * 16 + swz / 64; C = (st & 1) * 32 + (swz % 64) / 2; }
__host__ __device__ __forceinline__ int perm32(int rho) { const int n = rho >> 4, i = rho & 15; return 8 * (i >> 2) + 4 * n + (i & 3); }

struct Unit { int pm, pn, aux; };
struct Gemm { const bf16_t* A; const bf16_t* Bt; int M, N, K, lda; };

struct StaticOrder {
    int nM, nN, nwg, G, c;
    __host__ __device__ void init(int M, int N, int G_, int c_) { nM = M / BM; nN = N / BM; nwg = nM * nN; G = G_; c = c_; }
    __host__ __device__ bool next(int i, Unit& u) const {
        const long L = (long)i * G + c; if (L >= nwg) return false;
        int wgid = (int)L; { const int q = nwg / NXCD, r = nwg % NXCD, xcd = wgid % NXCD, off = wgid / NXCD; wgid = (xcd < r ? xcd * (q + 1) : r * (q + 1) + (xcd - r) * q) + off; }
        const int nig = WGM * nN, gid = wgid / nig, fm = gid * WGM, gsz = (nM - fm) < WGM ? (nM - fm) : WGM;
        u.pm = fm + ((wgid % nig) % gsz); u.pn = (wgid % nig) / gsz; u.aux = u.pn; return true;
    }
    __device__ __forceinline__ void a_ready(const Unit&) const {}
    __device__ __forceinline__ void done(const Unit&) const {}
};

typedef float f32x2_cv __attribute__((ext_vector_type(2))); typedef __bf16 bf16x2_cv __attribute__((ext_vector_type(2)));
__device__ __forceinline__ unsigned cvt_pk_bf16(float lo, float hi) { f32x2_cv v = {lo, hi}; bf16x2_cv b = __builtin_convertvector(v, bf16x2_cv); return __builtin_bit_cast(unsigned, b); }
typedef float f32x2 __attribute__((ext_vector_type(2)));
__device__ __forceinline__ f32x2 gelu_pk(f32x2 v) {
    const f32x2 av = __builtin_elementwise_abs(v), d = av * 0.2316418882f + 1.0f;
    f32x2 t; t.x = __builtin_amdgcn_rcpf(d.x); t.y = __builtin_amdgcn_rcpf(d.y);
    f32x2 q = t * 0.5307027145f + (-0.7265760135f); q = q * t + 0.7107068705f; q = q * t + (-0.142248368f); q = q * t + 0.127414796f; q = q * t;
    const f32x2 s = (v * v) * (-0.72134752044f);
    f32x2 e; e.x = __builtin_amdgcn_exp2f(s.x); e.y = __builtin_amdgcn_exp2f(s.y);
    const f32x2 m = v * (q * e), r = v - m;
    f32x2 o; o.x = v.x < 0.f ? m.x : r.x; o.y = v.y < 0.f ? m.y : r.y; return o;
}

template <int ACT  > struct EpiBf16 {
    static constexpr bool PERM = true, AFTER_DRAIN = false; static_assert(ACT == 0 || ACT == 1, "EpiBf16: ACT is 0 (none) or 1 (gelu_pk)");
    bf16_t* O; int ldc; const float* bias; int split_cols; size_t split_stride; float scale0;
    __device__ __forceinline__ void operator()(const f32x4 (&acc)[2][2][4][2], const Unit& u, int wr, int wc, int fr, int fq) const {
        const int row0 = u.pm * BM + wr * 64 + fr; int colt = u.pn * BM; bf16_t* base = O;
        float sc = 1.f; if (split_cols) { const int t = colt / split_cols; base += (size_t)t * split_stride; colt -= t * split_cols; if (t == 0) sc = scale0; }
        const int col0 = colt + wc * 32 + 8 * fq, bcol0 = u.pn * BM + wc * 32 + 8 * fq;
        f32x4 bv[2][2];
#pragma unroll
        for (int bj = 0; bj < 2; ++bj)
#pragma unroll
            for (int n = 0; n < 2; ++n) bv[bj][n] = bias ? *(const f32x4*)(bias + bcol0 + bj * HALF + 4 * n) : (f32x4){0.f, 0.f, 0.f, 0.f};
#pragma unroll
        for (int ai = 0; ai < 2; ++ai)
#pragma unroll
            for (int m = 0; m < 4; ++m) { bf16_t* rowp = base + (size_t)(row0 + ai * HALF + m * 16) * ldc + col0;
#pragma unroll
                for (int bj = 0; bj < 2; ++bj) { f32x4 v0 = acc[ai][bj][m][0] + bv[bj][0], v1 = acc[ai][bj][m][1] + bv[bj][1];
                    if (ACT == 1) { f32x2 a = gelu_pk((f32x2){v0[0], v0[1]}), b = gelu_pk((f32x2){v0[2], v0[3]}), c = gelu_pk((f32x2){v1[0], v1[1]}), d = gelu_pk((f32x2){v1[2], v1[3]});
                        v0 = (f32x4){a.x, a.y, b.x, b.y}; v1 = (f32x4){c.x, c.y, d.x, d.y}; }
                    v0 = v0 * sc; v1 = v1 * sc; u32x4 w; w.x = cvt_pk_bf16(v0[0], v0[1]); w.y = cvt_pk_bf16(v0[2], v0[3]); w.z = cvt_pk_bf16(v1[0], v1[1]); w.w = cvt_pk_bf16(v1[2], v1[3]);
                    *(u32x4*)(rowp + bj * HALF) = w; } }
    }
};

struct PanelStats {
    unsigned* xbuf;
    unsigned* cnt;
    unsigned* tmo;
    int ntn; float eps;
    unsigned code;
    __device__ __forceinline__ bool run(const f32x4 (&v)[2][2][4][2], const Unit& u, int wr, int wc, int fr, int fq, PG8_LAS unsigned char* lds, int wid, int lane) const {
        typedef float f32x2v __attribute__((ext_vector_type(2)));
        PG8_LAS f32x2v* P = (PG8_LAS f32x2v*)lds;
        PG8_LAS f32x2v* S = (PG8_LAS f32x2v*)(lds + 8192);
        PG8_LAS unsigned* flag = (PG8_LAS unsigned*)(lds + 8192 + 2048);
#pragma unroll
        for (int ai = 0; ai < 2; ++ai)
#pragma unroll
            for (int m = 0; m < 4; ++m) {
                float s = 0.f;
#pragma unroll
                for (int bj = 0; bj < 2; ++bj)
#pragma unroll
                    for (int n = 0; n < 2; ++n) { const f32x4 x = v[ai][bj][m][n]; s += (x[0] + x[1]) + (x[2] + x[3]); }
                s += __shfl_xor(s, 16); s += __shfl_xor(s, 32);
                const float mw = s * (1.0f / 64.0f); float q = 0.f;
#pragma unroll
                for (int bj = 0; bj < 2; ++bj)
#pragma unroll
                    for (int n = 0; n < 2; ++n) { const f32x4 d = v[ai][bj][m][n] - mw; q += (d[0] * d[0] + d[1] * d[1]) + (d[2] * d[2] + d[3] * d[3]); }
                q += __shfl_xor(q, 16); q += __shfl_xor(q, 32);
                if (fq == 0) P[(ai * HALF + wr * 64 + m * 16 + fr) * 4 + wc] = (f32x2v){mw, q};
            }
        asm volatile("s_waitcnt lgkmcnt(0)" ::: "memory"); __builtin_amdgcn_s_barrier(); asm volatile("" ::: "memory");
#if defined(BROKEN_EXCHANGE_NO_WAIT)
#warning BROKEN CONTROL BUILD: the row-statistics exchange does not wait; results are wrong by design
        if (blockIdx.x >= 64) { const long long t0_ = clock64(); while (clock64() - t0_ < 60000) __builtin_amdgcn_s_sleep(8); }
#endif
        const int row = wid * 32 + (lane & 31);
        if (lane < 32) {
            const f32x2v a = P[row * 4 + 0], b = P[row * 4 + 1], c = P[row * 4 + 2], d = P[row * 4 + 3];
            const float mt = (a.x + b.x + c.x + d.x) * 0.25f;
            const float da = a.x - mt, db = b.x - mt, dc = c.x - mt, dd = d.x - mt;
            const float m2 = (a.y + b.y) + (c.y + d.y) + 64.0f * ((da * da + db * db) + (dc * dc + dd * dd));
            unsigned long long* slot = (unsigned long long*)xbuf + ((size_t)(u.pm * BM + row) * 4 + u.pn);
            __hip_atomic_store(slot, ((unsigned long long)__float_as_uint(m2) << 32) | __float_as_uint(mt), __ATOMIC_RELAXED, __HIP_MEMORY_SCOPE_AGENT);
        }
        asm volatile("s_waitcnt vmcnt(0)" ::: "memory");
        if (lane == 0) __hip_atomic_fetch_add(cnt + 64 * u.pm, 1u, __ATOMIC_RELAXED, __HIP_MEMORY_SCOPE_AGENT);
        if (wid == 0) {
            bool dead = false; const unsigned long long t0 = __builtin_amdgcn_s_memrealtime(); const unsigned want = 8u * (unsigned)ntn;
            for (;;) {
#if defined(BROKEN_EXCHANGE_NO_WAIT)
                break;
#endif
                if ((unsigned)__builtin_amdgcn_readfirstlane(__hip_atomic_load(cnt + 64 * u.pm, __ATOMIC_RELAXED, __HIP_MEMORY_SCOPE_AGENT)) >= want) break;
                if (__builtin_amdgcn_s_memrealtime() - t0 > 2000000ull) {
                    if (lane == 0) { unsigned expect = 0u; __hip_atomic_compare_exchange_strong(tmo + 1, &expect, code | (unsigned)(u.pm & 0xff), __ATOMIC_RELAXED, __ATOMIC_RELAXED, __HIP_MEMORY_SCOPE_AGENT);
                                     __hip_atomic_store(tmo, 1u, __ATOMIC_RELAXED, __HIP_MEMORY_SCOPE_AGENT); }
                    dead = true; break; }
                __builtin_amdgcn_s_sleep(2);
            }
            __builtin_amdgcn_fence(__ATOMIC_ACQUIRE, "agent");
            if (lane == 0) flag[0] = dead ? 1u : 0u;
        }
        asm volatile("s_waitcnt vmcnt(0) lgkmcnt(0)" ::: "memory"); __builtin_amdgcn_s_barrier(); asm volatile("" ::: "memory");
        const bool bad = flag[0] != 0u;
        if (lane < 32) {
            const unsigned long long* slot = (const unsigned long long*)xbuf + (size_t)(u.pm * BM + row) * 4; float mt[4], m2[4]; float ms = 0.f;
#pragma unroll
            for (int t = 0; t < 4; ++t) { if (t < ntn) { const unsigned long long w = __hip_atomic_load(slot + t, __ATOMIC_RELAXED, __HIP_MEMORY_SCOPE_AGENT); mt[t] = __uint_as_float((unsigned)w); m2[t] = __uint_as_float((unsigned)(w >> 32)); } else { mt[t] = 0.f; m2[t] = 0.f; } ms += mt[t]; }
            const float mean = ms / (float)ntn; float q = 0.f;
#pragma unroll
            for (int t = 0; t < 4; ++t) if (t < ntn) { const float dm = mt[t] - mean; q += m2[t] + 256.0f * dm * dm; }
            S[row] = (f32x2v){mean, 1.0f / sqrtf(q / (256.0f * (float)ntn) + eps)};
        }
        asm volatile("s_waitcnt lgkmcnt(0)" ::: "memory"); __builtin_amdgcn_s_barrier(); asm volatile("" ::: "memory");
        return bad;
    }
};
struct EpiLnRes {
    static constexpr bool PERM = false, AFTER_DRAIN = true;
    const float* base; float* out; int ldc; const float* bias; PanelStats st; unsigned poison;
    __device__ __forceinline__ void fused(f32x4 (&acc)[2][2][4][2], const Unit& u, int wr, int wc, int fr, int fq, PG8_LAS unsigned char* lds, int wid, int lane) const {
        typedef float f32x2v __attribute__((ext_vector_type(2)));
        const PG8_LAS f32x2v* S = (const PG8_LAS f32x2v*)(lds + 8192);
        const int col0 = u.pn * BM + wc * 32 + 4 * fq;
#pragma unroll
        for (int bj = 0; bj < 2; ++bj)
#pragma unroll
            for (int n = 0; n < 2; ++n) { const f32x4 bv = bias ? *(const f32x4*)(bias + col0 + bj * HALF + n * 16) : (f32x4){0.f, 0.f, 0.f, 0.f};
#pragma unroll
                for (int ai = 0; ai < 2; ++ai)
#pragma unroll
                    for (int m = 0; m < 4; ++m) acc[ai][bj][m][n] += bv; }
        f32x4 pre[4][2][2];
#pragma unroll
        for (int m = 0; m < 4; ++m) { const size_t off = (size_t)(u.pm * BM + wr * 64 + m * 16 + fr) * ldc + col0;
#pragma unroll
            for (int bj = 0; bj < 2; ++bj)
#pragma unroll
                for (int n = 0; n < 2; ++n) pre[m][bj][n] = *(const f32x4*)(base + off + bj * HALF + n * 16); }
        const bool bad = st.run(acc, u, wr, wc, fr, fq, lds, wid, lane) || poison != 0u;
        const float qnan = __builtin_nanf("");
#pragma unroll
        for (int ai = 0; ai < 2; ++ai)
#pragma unroll
            for (int m = 0; m < 4; ++m) { const int r = ai * HALF + wr * 64 + m * 16 + fr; const f32x2v sr = S[r]; const size_t off = (size_t)(u.pm * BM + r) * ldc + col0;
#pragma unroll
                for (int bj = 0; bj < 2; ++bj)
#pragma unroll
                    for (int n = 0; n < 2; ++n) { const f32x4 bs = ai == 0 ? pre[m][bj][n] : *(const f32x4*)(base + off + bj * HALF + n * 16); f32x4 o = bs + (acc[ai][bj][m][n] - sr.x) * sr.y;
                        if (bad) o = (f32x4){qnan, qnan, qnan, qnan}; *(f32x4*)(out + off + bj * HALF + n * 16) = o; }
                if (m & 1) asm volatile("" ::: "memory"); }
    }
};
struct EpiLnResLn {
    static constexpr bool PERM = false, AFTER_DRAIN = true;
    const float* base; float* out; bf16_t* xn; int ldc; const float* bias; PanelStats st1, st2; unsigned poison;
    __device__ __forceinline__ void fused(f32x4 (&acc)[2][2][4][2], const Unit& u, int wr, int wc, int fr, int fq, PG8_LAS unsigned char* lds, int wid, int lane) const {
        typedef float f32x2v __attribute__((ext_vector_type(2))); typedef unsigned u32x2v __attribute__((ext_vector_type(2)));
        const PG8_LAS f32x2v* S = (const PG8_LAS f32x2v*)(lds + 8192);
        const int col0 = u.pn * BM + wc * 32 + 4 * fq;
#pragma unroll
        for (int bj = 0; bj < 2; ++bj)
#pragma unroll
            for (int n = 0; n < 2; ++n) { const f32x4 bv = bias ? *(const f32x4*)(bias + col0 + bj * HALF + n * 16) : (f32x4){0.f, 0.f, 0.f, 0.f};
#pragma unroll
                for (int ai = 0; ai < 2; ++ai)
#pragma unroll
                    for (int m = 0; m < 4; ++m) acc[ai][bj][m][n] += bv; }
        bool bad = st1.run(acc, u, wr, wc, fr, fq, lds, wid, lane) || poison != 0u;
        const float qnan = __builtin_nanf("");
#pragma unroll
        for (int ai = 0; ai < 2; ++ai)
#pragma unroll
            for (int m = 0; m < 4; ++m) { const int r = ai * HALF + wr * 64 + m * 16 + fr; const f32x2v sr = S[r]; const size_t off = (size_t)(u.pm * BM + r) * ldc + col0;
#pragma unroll
                for (int bj = 0; bj < 2; ++bj)
#pragma unroll
                    for (int n = 0; n < 2; ++n) { const f32x4 bs = *(const f32x4*)(base + off + bj * HALF + n * 16); acc[ai][bj][m][n] = bs + (acc[ai][bj][m][n] - sr.x) * sr.y; }
                asm volatile("" : "+v"(acc[ai][0][m][0]), "+v"(acc[ai][0][m][1]), "+v"(acc[ai][1][m][0]), "+v"(acc[ai][1][m][1]));
                if (m & 1) asm volatile("" ::: "memory"); }
        const bool bad1 = bad;
        bad = st2.run(acc, u, wr, wc, fr, fq, lds, wid, lane) || bad;
#pragma unroll
        for (int ai = 0; ai < 2; ++ai)
#pragma unroll
            for (int m = 0; m < 4; ++m) { const int r = ai * HALF + wr * 64 + m * 16 + fr; const f32x2v sr = S[r]; const size_t off = (size_t)(u.pm * BM + r) * ldc + col0;
#pragma unroll
                for (int bj = 0; bj < 2; ++bj)
#pragma unroll
                    for (int n = 0; n < 2; ++n) { const f32x4 x1 = acc[ai][bj][m][n]; *(f32x4*)(out + off + bj * HALF + n * 16) = bad1 ? (f32x4){qnan, qnan, qnan, qnan} : x1;
                        const f32x4 o = (x1 - sr.x) * sr.y; u32x2v w; w.x = cvt_pk_bf16(o[0], o[1]); w.y = cvt_pk_bf16(o[2], o[3]);
                        if (bad) { w.x = 0x7fc07fc0u; w.y = 0x7fc07fc0u; } *(u32x2v*)(xn + off + bj * HALF + n * 16) = w; }
                asm volatile("" ::: "memory"); }
    }
};

template <class Epi, class Sched, bool ALIGN_EPI = false, bool SP2 = false>
__device__ __forceinline__ void gemm_phase(PG8_LAS unsigned char* lds, const Gemm g, const Sched& S, const Epi& E, const int tid) {
    const int wid = __builtin_amdgcn_readfirstlane(tid >> 6), lane = tid & 63, wr = wid >> 2, wc = wid & 3, fr = lane & 15, fq = lane >> 4;
    const int K = g.K, nt = K / BK;
    unsigned voffA[2], voffB[2];
#pragma unroll
    for (int i = 0; i < 2; ++i) { int R, C; stage_rc(tid * 16 + i * 8192, R, C); const int Rb = Epi::PERM ? ((R & ~31) + perm32(R & 31)) : R;
        voffA[i] = (unsigned)(R * g.lda + C) * 2u; voffB[i] = (unsigned)(Rb * K + C) * 2u; }
    const size_t kstep = (size_t)(BK * 2);
    const size_t hstep = (size_t)HALF * K * 2, hstepA = (size_t)HALF * g.lda * 2;
    const size_t tstep = 2 * hstep, tstepA = 2 * hstepA;
    const unsigned ldsw = (unsigned)wid * 1024u;
    const int aoff = lds_byte(wr * 64 + fr, fq * 8), boff = lds_byte(wc * 32 + fr, fq * 8);
#define PG8_SA(b, h) (((b) * 2 + (h)) * HTB)
#define PG8_SB(b, h) ((4 + (b) * 2 + (h)) * HTB)
#define PG8_STAGE(bufoff, gbase, voff) do { _Pragma("unroll") for (int _i = 0; _i < 2; ++_i) \
        __builtin_amdgcn_global_load_lds((const unsigned*)((const char*)(gbase) + (voff)[_i]), (PG8_LAS unsigned*)(lds + (bufoff) + ldsw + _i * 8192), 16, 0, 0); } while (0)
#define PG8_LDA(dst, b, h) do { _Pragma("unroll") for (int m = 0; m < 4; ++m) _Pragma("unroll") for (int k = 0; k < 2; ++k) dst[m][k] = *(const PG8_LAS bf16x8*)(lds + PG8_SA(b, h) + aoff + m * 2048 + k * 1024); } while (0)
#define PG8_LDB(dst, b, h) do { _Pragma("unroll") for (int n = 0; n < 2; ++n) _Pragma("unroll") for (int k = 0; k < 2; ++k) dst[n][k] = *(const PG8_LAS bf16x8*)(lds + PG8_SB(b, h) + boff + n * 2048 + k * 1024); } while (0)
#define PG8_MMA(ai, bj, At, Bt) do { __builtin_amdgcn_s_setprio(1); _Pragma("unroll") for (int m = 0; m < 4; ++m) _Pragma("unroll") for (int n = 0; n < 2; ++n) _Pragma("unroll") for (int k = 0; k < 2; ++k) \
        acc[ai][bj][m][n] = __builtin_amdgcn_mfma_f32_16x16x32_bf16(Bt[n][k], At[m][k], acc[ai][bj][m][n], 0, 0, 0); __builtin_amdgcn_s_setprio(0); } while (0)
#define PG8_WAIT_V(n) asm volatile("s_waitcnt vmcnt(" #n ")" ::: "memory")
#define PG8_WAIT_L(n) asm volatile("s_waitcnt lgkmcnt(" #n ")" ::: "memory")
#define PG8_BAR __builtin_amdgcn_s_barrier()
#define PG8_SCHED __builtin_amdgcn_sched_barrier(0)
    Unit cur, nxt; int ui = 0;
    if (!S.next(0, cur)) return;
    f32x4 acc[2][2][4][2];
#pragma unroll
    for (int a = 0; a < 2; ++a)
#pragma unroll
        for (int b = 0; b < 2; ++b)
#pragma unroll
            for (int m = 0; m < 4; ++m)
#pragma unroll
                for (int n = 0; n < 2; ++n) acc[a][b][m][n] = (f32x4){0.f, 0.f, 0.f, 0.f};
    bf16x8 At[4][2], B0[2][2], B1[2][2];
    const char* cA = (const char*)g.A + (size_t)cur.pm * tstepA; const char* cB = (const char*)g.Bt + (size_t)cur.pn * tstep;
    S.a_ready(cur);
    if constexpr (SP2) {
        PG8_STAGE(PG8_SB(0, 0), cB, voffB); PG8_STAGE(PG8_SB(0, 1), cB + hstep, voffB); PG8_STAGE(PG8_SA(0, 0), cA, voffA); PG8_STAGE(PG8_SA(0, 1), cA + hstepA, voffA);
        if (wr == 1) PG8_BAR;
        PG8_WAIT_V(2); PG8_BAR;
        PG8_STAGE(PG8_SB(1, 0), cB + kstep, voffB); PG8_STAGE(PG8_SA(1, 0), cA + kstep, voffA); PG8_STAGE(PG8_SB(1, 1), cB + hstep + kstep, voffB);
        PG8_WAIT_V(6); PG8_BAR;
    } else {
        PG8_STAGE(PG8_SB(0, 0), cB, voffB); PG8_STAGE(PG8_SA(0, 0), cA, voffA); PG8_STAGE(PG8_SB(0, 1), cB + hstep, voffB); PG8_STAGE(PG8_SA(0, 1), cA + hstepA, voffA);
        if (wr == 1) PG8_BAR;
        PG8_WAIT_V(4); PG8_BAR;
        PG8_STAGE(PG8_SB(1, 0), cB + kstep, voffB); PG8_STAGE(PG8_SA(1, 0), cA + kstep, voffA); PG8_STAGE(PG8_SB(1, 1), cB + hstep + kstep, voffB);
        PG8_WAIT_V(6); PG8_BAR;
    }
    for (;;) {
        const bool has_next = S.next(ui + 1, nxt);
        const char* nA = has_next ? (const char*)g.A + (size_t)nxt.pm * tstepA : cA; const char* nB = has_next ? (const char*)g.Bt + (size_t)nxt.pn * tstep : cB;
        for (int t = 0; t < nt; t += 2) {
            const bool last = (t == nt - 2);
            const char* a1 = cA + (size_t)(t + 1) * kstep;
            const char* a2 = last ? nA : cA + (size_t)(t + 2) * kstep; const char* b2 = last ? nB : cB + (size_t)(t + 2) * kstep;
            const char* a3 = a2 + kstep; const char* b3 = b2 + kstep;
            if (last && has_next) S.a_ready(nxt);
            if constexpr (SP2) {
            PG8_LDB(B0, 0, 0); PG8_LDB(B1, 0, 1); PG8_SCHED; PG8_LDA(At, 0, 0); PG8_STAGE(PG8_SA(1, 1), a1 + hstepA, voffA);
            PG8_WAIT_V(8); PG8_WAIT_L(0); PG8_BAR; PG8_MMA(0, 0, At, B0); PG8_MMA(0, 1, At, B1); PG8_BAR; PG8_SCHED;
            PG8_LDA(At, 0, 1); PG8_STAGE(PG8_SB(0, 0), b2, voffB); PG8_STAGE(PG8_SB(0, 1), b2 + hstep, voffB); PG8_STAGE(PG8_SA(0, 0), a2, voffA);
            PG8_WAIT_V(8); PG8_WAIT_L(0); PG8_BAR; PG8_MMA(1, 0, At, B0); PG8_MMA(1, 1, At, B1); PG8_BAR; PG8_SCHED;
            PG8_LDB(B0, 1, 0); PG8_LDB(B1, 1, 1); PG8_SCHED; PG8_LDA(At, 1, 0); PG8_STAGE(PG8_SA(0, 1), a2 + hstepA, voffA);
            PG8_WAIT_V(8); PG8_WAIT_L(0); PG8_BAR; PG8_MMA(0, 0, At, B0); PG8_MMA(0, 1, At, B1); PG8_BAR; PG8_SCHED;
            PG8_LDA(At, 1, 1); PG8_STAGE(PG8_SB(1, 0), b3, voffB); PG8_STAGE(PG8_SB(1, 1), b3 + hstep, voffB); PG8_STAGE(PG8_SA(1, 0), a3, voffA);
            PG8_WAIT_V(8); PG8_WAIT_L(0); PG8_BAR; PG8_MMA(1, 0, At, B0); PG8_MMA(1, 1, At, B1); PG8_BAR; PG8_SCHED;
            } else {
            PG8_LDB(B0, 0, 0); PG8_SCHED; PG8_LDA(At, 0, 0); PG8_STAGE(PG8_SA(1, 1), a1 + hstepA, voffA);
            PG8_WAIT_L(8); PG8_BAR; PG8_WAIT_L(0); PG8_MMA(0, 0, At, B0); PG8_BAR; PG8_SCHED;
            PG8_LDB(B1, 0, 1); PG8_STAGE(PG8_SB(0, 0), b2, voffB);
            PG8_BAR; PG8_WAIT_L(0); PG8_MMA(0, 1, At, B1); PG8_BAR;
            PG8_LDA(At, 0, 1); PG8_STAGE(PG8_SA(0, 0), a2, voffA);
            PG8_BAR; PG8_WAIT_L(0); PG8_MMA(1, 0, At, B0); PG8_BAR; PG8_SCHED;
            PG8_STAGE(PG8_SB(0, 1), b2 + hstep, voffB);
            PG8_WAIT_V(6); PG8_BAR; PG8_MMA(1, 1, At, B1); PG8_BAR;
            PG8_LDB(B0, 1, 0); PG8_SCHED; PG8_LDA(At, 1, 0); PG8_STAGE(PG8_SA(0, 1), a2 + hstepA, voffA);
            PG8_WAIT_L(8); PG8_BAR; PG8_WAIT_L(0); PG8_MMA(0, 0, At, B0); PG8_BAR; PG8_SCHED;
            PG8_LDB(B1, 1, 1); PG8_STAGE(PG8_SB(1, 0), b3, voffB);
            PG8_BAR; PG8_WAIT_L(0); PG8_MMA(0, 1, At, B1); PG8_BAR;
            PG8_LDA(At, 1, 1); PG8_STAGE(PG8_SA(1, 0), a3, voffA);
            PG8_BAR; PG8_WAIT_L(0); PG8_MMA(1, 0, At, B0); PG8_BAR; PG8_SCHED;
            PG8_STAGE(PG8_SB(1, 1), b3 + hstep, voffB);
            PG8_WAIT_V(6); PG8_BAR; PG8_MMA(1, 1, At, B1); PG8_BAR;
            }
        }
        if constexpr (ALIGN_EPI) { if (wr == 0) PG8_BAR; }
        if constexpr (!Epi::AFTER_DRAIN) { E(acc, cur, wr, wc, fr, fq); S.done(cur); }
        if (!has_next) break;
#pragma unroll
        for (int a = 0; a < 2; ++a)
#pragma unroll
            for (int b = 0; b < 2; ++b)
#pragma unroll
                for (int m = 0; m < 4; ++m)
#pragma unroll
                    for (int n = 0; n < 2; ++n) acc[a][b][m][n] = (f32x4){0.f, 0.f, 0.f, 0.f};
        cur = nxt; cA = nA; cB = nB; ++ui;
        if constexpr (ALIGN_EPI) { if (wr == 1) PG8_BAR; }
    }
    PG8_WAIT_V(0);
    if constexpr (!ALIGN_EPI) { if (wr == 0) PG8_BAR; }
    PG8_BAR;
    if constexpr (Epi::AFTER_DRAIN) { E.fused(acc, cur, wr, wc, fr, fq, lds, wid, lane); S.done(cur); }
#undef PG8_SA
#undef PG8_SB
#undef PG8_STAGE
#undef PG8_LDA
#undef PG8_LDB
#undef PG8_MMA
#undef PG8_WAIT_V
#undef PG8_WAIT_L
#undef PG8_BAR
#undef PG8_SCHED
}
}


#define GAS __attribute__((address_space(1)))
#define LAS __attribute__((address_space(3)))
typedef unsigned short bf16;
typedef unsigned v4u __attribute__((ext_vector_type(4)));
typedef unsigned v2u __attribute__((ext_vector_type(2)));
typedef float f32x4 __attribute__((ext_vector_type(4)));
typedef short bf16x8 __attribute__((ext_vector_type(8)));
#define RLX_AGENT __ATOMIC_RELAXED, __HIP_MEMORY_SCOPE_AGENT
#define LDS_WAIT() asm volatile("s_waitcnt lgkmcnt(0)" ::: "memory")
#define VM_WAIT() asm volatile("s_waitcnt vmcnt(0)" ::: "memory")

#ifndef MK_ONE_LAUNCH
#define MK_ONE_LAUNCH 0
#endif
#ifndef PROBE
#define PROBE 0
#endif

constexpr int T = 32768, SEQ = 16384, DM = 1024, DEPTH = 2;
constexpr int DIN = 7184;
constexpr int PW = 4352;
constexpr int C_RGX = 0, C_GQ = 512, C_GK = 768, C_GV = 1024, C_GG = 1536, C_HQ = 2048, C_HF = 2560, C_HI = 3072, C_HG = 3584, C_GA = 4096;
constexpr int DFF = 2816, DFFE = 3584, NEXP = 8;
constexpr float ALPHA = 1.4142135623730951f;
constexpr float LN_EPS = 1e-5f, RMS_EPS = 1e-6f;
constexpr int NWAVES = 8, NTHR = 512;
constexpr int MOE_CHUNK_PANELS = 64, MOE_NCHUNK = 5, MOE_MAXP = 320;

constexpr size_t MiB = 1u << 20;
constexpr size_t WS_CTL = 0, CTL_ZERO_BYTES = 1 * MiB;
constexpr size_t WS_SMALL = 1 * MiB;
constexpr size_t WS_TOKOF = 2 * MiB, WS_WOF = 3 * MiB;
constexpr size_t WS_WINA = 4 * MiB;
constexpr size_t WS_WGATE = 21 * MiB;
constexpr size_t WS_WBR = 33 * MiB;
constexpr size_t WS_WOUT = 39 * MiB;
constexpr size_t WS_WGU = 43 * MiB;
constexpr size_t WS_WD = 54 * MiB;
constexpr size_t WS_XB = 60 * MiB;
constexpr size_t WS_PROJ = 124 * MiB;
constexpr size_t WS_TEMPS = 396 * MiB;
constexpr size_t WS_RGA = 396 * MiB, WS_RGB = 460 * MiB;
constexpr size_t WS_G0 = 396 * MiB, WS_G1 = 460 * MiB;
constexpr size_t WS_X1B = 476 * MiB;
constexpr size_t WS_END = 540 * MiB;
constexpr size_t WS_MWGU = 4 * MiB;
constexpr size_t WS_MWD = 116 * MiB;
constexpr size_t WS_HC = 172 * MiB;
constexpr size_t WS_XS = 284 * MiB;
constexpr size_t WS_ENT = 316 * MiB;
constexpr size_t WS_YS0 = 320 * MiB, WS_YS1 = 384 * MiB;
static_assert(WS_YS1 + 64 * MiB <= WS_X1B, "moe overlay");

constexpr size_t WS_RGW = WS_SMALL;
constexpr size_t WS_RGSP = 396 * MiB, WS_RGSH = 397 * MiB, WS_RGCARRY = 398 * MiB, WS_RGHALO = 399 * MiB;
constexpr int CW_TMO = 0, CW_CODE = 1;
constexpr int CW_MOECNT = 64;
constexpr int CW_BAR = 4096;

constexpr int RING_BYTES = 131072;
constexpr int MISC_OFF = RING_BYTES;
constexpr int MOETAB_OFF = RING_BYTES + 1024;
constexpr int LDS_BYTES = 147456;

__device__ __forceinline__ unsigned f2bf(float f) { unsigned u = __builtin_bit_cast(unsigned, f); return (u + 0x7fffu + ((u >> 16) & 1u)) >> 16; }
__device__ __forceinline__ unsigned pk2(float lo, float hi) { return f2bf(lo) | (f2bf(hi) << 16); }
__device__ __forceinline__ float bf2f(bf16 b) { return __builtin_bit_cast(float, ((unsigned)b) << 16); }
__device__ __forceinline__ float bflo(unsigned w) { return __builtin_bit_cast(float, w << 16); }
__device__ __forceinline__ float bfhi(unsigned w) { return __builtin_bit_cast(float, w & 0xffff0000u); }
__device__ __forceinline__ float sigmoidf_(float x) { return 1.0f / (1.0f + __expf(-x)); }
__device__ __forceinline__ float wave_sum(float v) {
#pragma unroll
    for (int o = 1; o < 64; o <<= 1) v += __shfl_xor(v, o);
    return v;
}
__device__ __forceinline__ float wave_sum_l(float v, int lane) {
#pragma unroll
    for (int o = 1; o < 64; o <<= 1) v += __builtin_bit_cast(float, __builtin_amdgcn_ds_bpermute((lane ^ o) << 2, __builtin_bit_cast(int, v)));
    return v;
}

#define XB_TMO      128
#define XB_XCNT(j)  (256  + 64 * (j))
#define XB_XSUB(j)  (1280 + 64 * (j))
#define XB_XGEN(j)  (2304 + 64 * (j))
#define XB_TOP      3328
#define XB_TOPGEN   3392
#define XCD_BAR_WORDS 3456
#define XB_SPIN_CAP (1u << 22)
__device__ __forceinline__ unsigned xb_ld(unsigned* p)              { return __hip_atomic_load(p, __ATOMIC_RELAXED, __HIP_MEMORY_SCOPE_AGENT); }
__device__ __forceinline__ unsigned xb_add(unsigned* p, unsigned v) { return __hip_atomic_fetch_add(p, v, __ATOMIC_RELAXED, __HIP_MEMORY_SCOPE_AGENT); }
__device__ __forceinline__ unsigned xb_xcc_id() { return (unsigned)__builtin_amdgcn_s_getreg((3 << 11) | 20) & 0xFu; }
#define XB_SPIN(cond, bar) do { unsigned _sp = 0; while (cond) { __builtin_amdgcn_s_sleep(1); \
    if ((++_sp & 255u) == 0u) { if (xb_ld(&(bar)[XB_TMO])) break; if (_sp > XB_SPIN_CAP) { atomicAdd(&(bar)[XB_TMO], 1u); break; } } } } while (0)
struct XcdBarrier { unsigned* bar; unsigned x; volatile LAS unsigned* st; };
__device__ __forceinline__ XcdBarrier xcd_barrier_post(unsigned* bar, volatile LAS unsigned* st) {
    XcdBarrier b; b.bar = bar; b.x = xb_xcc_id(); b.st = st;
    if (threadIdx.x == 0) (void)xb_add(&bar[XB_XCNT(b.x)], 1u);
    return b;
}
__device__ __forceinline__ void xcd_barrier_complete(unsigned* bar, unsigned x, unsigned& nloc, unsigned& nx) {
    const unsigned G = gridDim.x * gridDim.y * gridDim.z;
    unsigned sum, cnt, mine, sp = 0u;
    for (;;) {
        sum = 0u; cnt = 0u; mine = 0u;
#pragma unroll
        for (unsigned j = 0; j < 16; ++j) { const unsigned c = xb_ld(&bar[XB_XCNT(j)]); sum += c; cnt += (c > 0u) ? 1u : 0u; mine = (j == x) ? c : mine; }
        if (sum == G) break;
        __builtin_amdgcn_s_sleep(1);
        if ((++sp & 255u) == 0u) { if (xb_ld(&bar[XB_TMO])) break; if (sp > XB_SPIN_CAP) { atomicAdd(&bar[XB_TMO], 1u); break; } }
    }
    nloc = mine > 0u ? mine : 1u; nx = cnt > 0u ? cnt : 1u;
}
__device__ __forceinline__ void xcd_barrier(const XcdBarrier& b) {
    asm volatile("s_waitcnt vmcnt(0)" ::: "memory");
    __syncthreads();
    if (threadIdx.x == 0) {
        unsigned* bar = b.bar;
        __builtin_amdgcn_s_waitcnt(0);
        unsigned nloc = b.st[0], nx = b.st[1];
        if (nloc == 0u) { xcd_barrier_complete(bar, b.x, nloc, nx); b.st[0] = nloc; b.st[1] = nx; }
        const unsigned old = xb_add(&bar[XB_XSUB(b.x)], 1u);
        const unsigned gen = old / nloc;
        if (old + 1u == (gen + 1u) * nloc) {
            __builtin_amdgcn_fence(__ATOMIC_RELEASE, "agent");
            asm volatile("s_waitcnt vmcnt(0)" ::: "memory");
            const unsigned og = xb_add(&bar[XB_TOP], 1u);
            const unsigned tg = og / nx;
            if (og + 1u == (tg + 1u) * nx) xb_add(&bar[XB_TOPGEN], 1u);
            else XB_SPIN(xb_ld(&bar[XB_TOPGEN]) == tg, bar);
            __builtin_amdgcn_fence(__ATOMIC_ACQUIRE, "agent");
            xb_add(&bar[XB_XGEN(b.x)], 1u);
            asm volatile("s_waitcnt vmcnt(0)" ::: "memory");
        } else {
            XB_SPIN(xb_ld(&bar[XB_XGEN(b.x)]) == gen, bar);
            __builtin_amdgcn_fence(__ATOMIC_ACQUIRE, "agent");
            asm volatile("s_waitcnt vmcnt(0)" ::: "memory");
        }
    }
    __syncthreads();
}

struct Args { const float* in[27]; float* out; unsigned char* ws; int ph_lo, ph_hi, li, pad; };
typedef const float* const __attribute__((address_space(4)))* inptr_t;
typedef const unsigned char __attribute__((address_space(4)))* kptr_t;
struct Ctx {
    LAS unsigned char* lds;
    unsigned* ctl;
    int tid, lane, wave, cu, G;
    inptr_t in;
    float* R;
    unsigned char* ws;
};
enum { I_X = 0, I_WIN, I_CONVW, I_CONVB, I_RGWR, I_RGBR, I_RGWI, I_RGBI, I_RGLAM, I_GLAWA, I_GLABA, I_GLANW, I_HGLB, I_HGNW, I_WBR, I_WOUT,
       I_LN1G, I_LN1B, I_LN2G, I_LN2B, I_FFNWG, I_FFNWU, I_FFNWD, I_ROUTER, I_MOEWG, I_MOEWU, I_MOEWD };

template <class Map>
__device__ __forceinline__ void tr_item(const float* W, int N, LAS float* scr, int kb, int nb, int lane, Map map) {
    const int k0 = 64 * kb, n0 = 32 * nb;
    const int cc = n0 + (lane & 31);
#pragma unroll 8
    for (int i = 0; i < 32; ++i) { const int kk = 2 * i + (lane >> 5); scr[kk * 33 + (lane & 31)] = (cc < N) ? W[(size_t)(k0 + kk) * N + cc] : 0.f; }
    LDS_WAIT(); asm volatile("" ::: "memory");
    const int c = lane & 7;
#pragma unroll
    for (int j = 0; j < 4; ++j) { const int n = (lane >> 3) + 8 * j; const LAS float* s = scr + (8 * c) * 33 + n;
        if (n0 + n < N) { bf16* dst = map(n0 + n);
            if (dst) { v4u o; o.x = pk2(s[0 * 33], s[1 * 33]); o.y = pk2(s[2 * 33], s[3 * 33]); o.z = pk2(s[4 * 33], s[5 * 33]); o.w = pk2(s[6 * 33], s[7 * 33]);
                *(v4u*)(dst + k0 + 8 * c) = o; } } }
    LDS_WAIT(); asm volatile("" ::: "memory");
}

__device__ __forceinline__ void phase_conv(Ctx& C) {
    LAS float* scr = (LAS float*)(C.lds + C.wave * 16384);
    const int gw = C.cu * NWAVES + C.wave, NGW = C.G * NWAVES;
    bf16* WINA = (bf16*)(C.ws + WS_WINA); bf16* WGATE = (bf16*)(C.ws + WS_WGATE); bf16* WBR = (bf16*)(C.ws + WS_WBR);
    bf16* WOUT = (bf16*)(C.ws + WS_WOUT); bf16* WGU = (bf16*)(C.ws + WS_WGU); bf16* WD = (bf16*)(C.ws + WS_WD);
    constexpr int I_IN = 16 * 225, I_BR = 8 * 32, I_OUT = 16 * 32, I_GU = 16 * 88, I_D = 44 * 32;
    constexpr int NIT = 2 * I_IN + 6 * I_BR + 2 * I_OUT + 2 * I_GU + I_D;
    for (int it = gw; it < NIT; it += NGW) {
        int r = it;
        if (r < 2 * I_IN) { const int l = r / I_IN; r -= l * I_IN; const int kb = r / 225, nb = r % 225;
            bf16* a = WINA + (size_t)l * PW * DM; bf16* g = WGATE + (size_t)l * 3072 * DM;
            tr_item(C.in[I_WIN] + (size_t)l * DM * DIN, DIN, scr, kb, nb, C.lane, [=](int c) -> bf16* {
                int d; if (c < 1536) d = c; else if (c < 1552) d = C_GA + (c - 1536); else if (c < 2064) d = C_GG + (c - 1552); else if (c < 4112) d = C_HQ + (c - 2064); else return g + (size_t)(c - 4112) * DM;
                return a + (size_t)d * DM; });
            continue; }
        r -= 2 * I_IN;
        if (r < 6 * I_BR) { const int m = r / I_BR; r -= m * I_BR; const int kb = r / 32, nb = r % 32; bf16* d = WBR + (size_t)m * 1024 * 512;
            tr_item(C.in[I_WBR] + (size_t)m * 512 * 1024, 1024, scr, kb, nb, C.lane, [=](int c) -> bf16* { return d + (size_t)c * 512; }); continue; }
        r -= 6 * I_BR;
        if (r < 2 * I_OUT) { const int l = r / I_OUT; r -= l * I_OUT; const int kb = r / 32, nb = r % 32; bf16* d = WOUT + (size_t)l * 1024 * 1024;
            tr_item(C.in[I_WOUT] + (size_t)l * 1024 * 1024, 1024, scr, kb, nb, C.lane, [=](int c) -> bf16* { return d + (size_t)c * 1024; }); continue; }
        r -= 2 * I_OUT;
        if (r < 2 * I_GU) { const int u = r / I_GU; r -= u * I_GU; const int kb = r / 88, nb = r % 88;
            tr_item(u ? C.in[I_FFNWU] : C.in[I_FFNWG], DFF, scr, kb, nb, C.lane, [=](int c) -> bf16* { return WGU + (size_t)((c >> 7) * 256 + u * 128 + (c & 127)) * 1024; }); continue; }
        r -= 2 * I_GU;
        { const int kb = r / 32, nb = r % 32; tr_item(C.in[I_FFNWD], 1024, scr, kb, nb, C.lane, [=](int c) -> bf16* { return WD + (size_t)c * DFF; }); }
    }
    { bf16* RW = (bf16*)(C.ws + WS_RGW);
      for (int i = gw * 64 + C.lane; i < 2 * 2 * 8 * 4096; i += NGW * 64) { const int in_ = i & 63, out = (i >> 6) & 63, g = (i >> 12) & 7, wh = (i >> 15) & 1, l = i >> 16;
          const float* src = wh ? C.in[I_RGWI] : C.in[I_RGWR]; RW[i] = (bf16)f2bf(src[((size_t)(l * 8 + g) * 64 + in_) * 64 + out]); } }
    for (int i = gw * 64 + C.lane; i < 2 * 240 * (DM / 8); i += NGW * 64) { const int l = i / (240 * 128), rr = (i / 128) % 240, ch = i % 128;
        *(v4u*)(WINA + ((size_t)l * PW + 4112 + rr) * DM + ch * 8) = (v4u){0u, 0u, 0u, 0u}; }
    const f32x4* x4 = (const f32x4*)C.in[I_X]; v4u* xb = (v4u*)(C.ws + WS_XB);
    for (size_t i = (size_t)gw * 64 + C.lane; i < (size_t)T * DM / 8; i += (size_t)NGW * 64) { const f32x4 a = x4[2 * i], b = x4[2 * i + 1];
        v4u o; o.x = pk2(a[0], a[1]); o.y = pk2(a[2], a[3]); o.z = pk2(b[0], b[1]); o.w = pk2(b[2], b[3]); xb[i] = o; }
}

__device__ __forceinline__ void phase_conv_moe(Ctx& C) {
    LAS float* scr = (LAS float*)(C.lds + C.wave * 16384);
    const int gw = C.cu * NWAVES + C.wave, NGW = C.G * NWAVES;
    bf16* MWGU = (bf16*)(C.ws + WS_MWGU); bf16* MWD = (bf16*)(C.ws + WS_MWD);
    constexpr int I_G = 16 * 112, I_D = 56 * 32;
    constexpr int NIT = NEXP * (2 * I_G + I_D);
    for (int it = gw; it < NIT; it += NGW) {
        const int e = it / (2 * I_G + I_D); int r = it % (2 * I_G + I_D);
        if (r < 2 * I_G) { const int u = r / I_G; r -= u * I_G; const int kb = r / 112, nb = r % 112; bf16* d = MWGU + (size_t)e * 7168 * 1024;
            tr_item((u ? C.in[I_MOEWU] : C.in[I_MOEWG]) + (size_t)e * 1024 * DFFE, DFFE, scr, kb, nb, C.lane, [=](int c) -> bf16* { return d + (size_t)((c >> 7) * 256 + u * 128 + (c & 127)) * 1024; }); continue; }
        r -= 2 * I_G;
        { const int kb = r / 32, nb = r % 32; bf16* d = MWD + (size_t)e * 1024 * DFFE;
          tr_item(C.in[I_MOEWD] + (size_t)e * DFFE * 1024, 1024, scr, kb, nb, C.lane, [=](int c) -> bf16* { return d + (size_t)c * DFFE; }); }
    }
}

template <bool MOE>
__device__ __forceinline__ void phase_ln(Ctx& C, const float* gam, const float* bet, bf16* xb_out) {
    const int gw = C.cu * NWAVES + C.wave, NGW = C.G * NWAVES;
    const bf16* ys0 = (const bf16*)(C.ws + WS_YS0); const bf16* ys1 = (const bf16*)(C.ws + WS_YS1);
    for (int m = gw; m < T; m += NGW) {
        f32x4* xr = (f32x4*)(C.R + (size_t)m * DM) + C.lane;
        f32x4 v[4]; float s = 0.f;
#pragma unroll
        for (int j = 0; j < 4; ++j) { v[j] = xr[64 * j];
            if (MOE) { const v2u a = *((const v2u*)(ys0 + (size_t)m * DM) + C.lane + 64 * j), b = *((const v2u*)(ys1 + (size_t)m * DM) + C.lane + 64 * j);
                v[j] = v[j] * ALPHA; v[j][0] += bflo(a.x) + bflo(b.x); v[j][1] += bfhi(a.x) + bfhi(b.x); v[j][2] += bflo(a.y) + bflo(b.y); v[j][3] += bfhi(a.y) + bfhi(b.y); }
            s += (v[j][0] + v[j][1]) + (v[j][2] + v[j][3]); }
        const float mean = wave_sum_l(s, C.lane) * (1.f / DM); float s2 = 0.f;
#pragma unroll
        for (int j = 0; j < 4; ++j) { v[j] = v[j] - mean; s2 += (v[j][0] * v[j][0] + v[j][1] * v[j][1]) + (v[j][2] * v[j][2] + v[j][3] * v[j][3]); }
        const float rstd = 1.f / sqrtf(wave_sum_l(s2, C.lane) * (1.f / DM) + LN_EPS);
#pragma unroll
        for (int j = 0; j < 4; ++j) { const f32x4 g4 = ((const f32x4*)gam)[C.lane + 64 * j], b4 = ((const f32x4*)bet)[C.lane + 64 * j];
            const f32x4 y = v[j] * rstd * g4 + b4; xr[64 * j] = y;
            if (xb_out) { v2u o; o.x = pk2(y[0], y[1]); o.y = pk2(y[2], y[3]); *((v2u*)(xb_out + (size_t)m * DM) + C.lane + 64 * j) = o; } }
    }
}

namespace pg8 {
struct EpiSig {
    static constexpr bool PERM = true, AFTER_DRAIN = false;
    bf16_t* O; int ldc;
    __device__ __forceinline__ void operator()(const f32x4 (&acc)[2][2][4][2], const Unit& u, int wr, int wc, int fr, int fq) const {
        const int row0 = u.pm * BM + wr * 64 + fr, col0 = u.pn * BM + wc * 32 + 8 * fq;
#pragma unroll
        for (int ai = 0; ai < 2; ++ai)
#pragma unroll
            for (int m = 0; m < 4; ++m) { bf16_t* rowp = O + (size_t)(row0 + ai * HALF + m * 16) * ldc + col0;
#pragma unroll
                for (int bj = 0; bj < 2; ++bj) { f32x4 v0 = acc[ai][bj][m][0], v1 = acc[ai][bj][m][1];
#pragma unroll
                    for (int j = 0; j < 4; ++j) { v0[j] = __builtin_amdgcn_rcpf(1.0f + __expf(-v0[j])); v1[j] = __builtin_amdgcn_rcpf(1.0f + __expf(-v1[j])); }
                    u32x4 w; w.x = cvt_pk_bf16(v0[0], v0[1]); w.y = cvt_pk_bf16(v0[2], v0[3]); w.z = cvt_pk_bf16(v1[0], v1[1]); w.w = cvt_pk_bf16(v1[2], v1[3]);
                    *(u32x4*)(rowp + bj * HALF) = w; } }
    }
};
struct EpiBranch {
    static constexpr bool PERM = true, AFTER_DRAIN = false;
    const bf16_t* G; int ldg; bf16_t* mixed; int first; const float* ssq4;
    __device__ __forceinline__ void operator()(const f32x4 (&acc)[2][2][4][2], const Unit& u, int wr, int wc, int fr, int fq) const {
        const int row0 = u.pm * BM + wr * 64 + fr, col0 = u.pn * BM + wc * 32 + 8 * fq;
#pragma unroll
        for (int ai = 0; ai < 2; ++ai)
#pragma unroll
            for (int m = 0; m < 4; ++m) { const size_t r = (size_t)(row0 + ai * HALF + m * 16);
                float rsc = 1.f; if (ssq4) { const f32x4 s4 = *(const f32x4*)(ssq4 + r * 4); rsc = 1.f / sqrtf(((s4[0] + s4[1]) + (s4[2] + s4[3])) * (1.f / 512.f) + 1e-6f); }
#pragma unroll
                for (int bj = 0; bj < 2; ++bj) {
                    const u32x4 g = *(const u32x4*)(G + r * ldg + col0 + bj * HALF);
                    u32x4 p = (u32x4){0u, 0u, 0u, 0u}; if (!first) p = *(const u32x4*)(mixed + r * 1024 + col0 + bj * HALF);
                    const f32x4 v0 = acc[ai][bj][m][0] * rsc, v1 = acc[ai][bj][m][1] * rsc;
                    float o0 = __uint_as_float(p.x << 16) + __uint_as_float(g.x << 16) * v0[0], o1 = __uint_as_float(p.x & 0xffff0000u) + __uint_as_float(g.x & 0xffff0000u) * v0[1];
                    float o2 = __uint_as_float(p.y << 16) + __uint_as_float(g.y << 16) * v0[2], o3 = __uint_as_float(p.y & 0xffff0000u) + __uint_as_float(g.y & 0xffff0000u) * v0[3];
                    float o4 = __uint_as_float(p.z << 16) + __uint_as_float(g.z << 16) * v1[0], o5 = __uint_as_float(p.z & 0xffff0000u) + __uint_as_float(g.z & 0xffff0000u) * v1[1];
                    float o6 = __uint_as_float(p.w << 16) + __uint_as_float(g.w << 16) * v1[2], o7 = __uint_as_float(p.w & 0xffff0000u) + __uint_as_float(g.w & 0xffff0000u) * v1[3];
                    u32x4 w; w.x = cvt_pk_bf16(o0, o1); w.y = cvt_pk_bf16(o2, o3); w.z = cvt_pk_bf16(o4, o5); w.w = cvt_pk_bf16(o6, o7);
                    *(u32x4*)(mixed + r * 1024 + col0 + bj * HALF) = w; } }
    }
};
struct EpiResid {
    static constexpr bool PERM = false, AFTER_DRAIN = false;
    const float* base; float* out; float alpha;
    __device__ __forceinline__ void operator()(const f32x4 (&acc)[2][2][4][2], const Unit& u, int wr, int wc, int fr, int fq) const {
        const int row0 = u.pm * BM + wr * 64 + fr, col0 = u.pn * BM + wc * 32 + 4 * fq;
#pragma unroll
        for (int ai = 0; ai < 2; ++ai)
#pragma unroll
            for (int m = 0; m < 4; ++m) { const size_t off = (size_t)(row0 + ai * HALF + m * 16) * 1024 + col0;
#pragma unroll
                for (int bj = 0; bj < 2; ++bj)
#pragma unroll
                    for (int n = 0; n < 2; ++n) { const f32x4 bs = *(const f32x4*)(base + off + bj * HALF + n * 16); *(f32x4*)(out + off + bj * HALF + n * 16) = bs * alpha + acc[ai][bj][m][n]; } }
    }
};
struct EpiSwiGLU {
    static constexpr bool PERM = true, AFTER_DRAIN = false;
    bf16_t* H; int ldh;
    __device__ __forceinline__ void operator()(const f32x4 (&acc)[2][2][4][2], const Unit& u, int wr, int wc, int fr, int fq) const {
        const int row0 = u.pm * BM + wr * 64 + fr, col0 = u.aux * HALF + wc * 32 + 8 * fq;
#pragma unroll
        for (int ai = 0; ai < 2; ++ai)
#pragma unroll
            for (int m = 0; m < 4; ++m) { bf16_t* rowp = H + (size_t)(row0 + ai * HALF + m * 16) * ldh + col0;
                f32x4 h0, h1;
#pragma unroll
                for (int j = 0; j < 4; ++j) { const float g0 = acc[ai][0][m][0][j], g1 = acc[ai][0][m][1][j];
                    h0[j] = g0 * __builtin_amdgcn_rcpf(1.0f + __expf(-g0)) * acc[ai][1][m][0][j]; h1[j] = g1 * __builtin_amdgcn_rcpf(1.0f + __expf(-g1)) * acc[ai][1][m][1][j]; }
                u32x4 w; w.x = cvt_pk_bf16(h0[0], h0[1]); w.y = cvt_pk_bf16(h0[2], h0[3]); w.z = cvt_pk_bf16(h1[0], h1[1]); w.w = cvt_pk_bf16(h1[2], h1[3]);
                *(u32x4*)rowp = w; }
    }
};
struct EpiMoeDown {
    static constexpr bool PERM = true, AFTER_DRAIN = false;
    const int* ent; const float* pw; bf16_t *YS0, *YS1;
    __device__ __forceinline__ void operator()(const f32x4 (&acc)[2][2][4][2], const Unit& u, int wr, int wc, int fr, int fq) const {
        const int row0 = u.pm * BM + wr * 64 + fr, col0 = (u.pn & 3) * BM + wc * 32 + 8 * fq;
#pragma unroll
        for (int ai = 0; ai < 2; ++ai)
#pragma unroll
            for (int m = 0; m < 4; ++m) { const int r = row0 + ai * HALF + m * 16; const int en = ent[r]; const float p = pw[r];
                if (en >= 0) { bf16_t* rowp = ((en & 1) ? YS1 : YS0) + (size_t)(en >> 1) * 1024 + col0;
#pragma unroll
                    for (int bj = 0; bj < 2; ++bj) { const f32x4 v0 = acc[ai][bj][m][0] * p, v1 = acc[ai][bj][m][1] * p;
                        u32x4 w; w.x = cvt_pk_bf16(v0[0], v0[1]); w.y = cvt_pk_bf16(v0[2], v0[3]); w.z = cvt_pk_bf16(v1[0], v1[1]); w.w = cvt_pk_bf16(v1[2], v1[3]);
                        *(u32x4*)(rowp + bj * HALF) = w; } } }
    }
};
struct MoeOrder {
    const PG8_LAS int* pe; int pbase, np, G, c, nt, bt;
    __device__ __forceinline__ bool next(int i, Unit& u) const {
        const int L = i * G + c; if (L >= np * nt) return false;
        const int pl = L / nt, pn = L - pl * nt; const int e = pe[pbase + pl];
        u.pm = pl; u.pn = e * bt + pn; u.aux = pn; return true;
    }
    __device__ __forceinline__ void a_ready(const Unit&) const {}
    __device__ __forceinline__ void done(const Unit&) const {}
};
}

template <int K, bool GLA>
__device__ __forceinline__ void mix_naive(Ctx& C, int l, int b) {
    constexpr int TB = 8;
    LAS float* dec = (LAS float*)C.lds;
    LAS float* kk = dec + TB * 4 * K;
    LAS float* qq = kk + TB * 4 * K;
    LAS float* ob = qq + TB * 4 * K;
    LAS float* part = ob + TB * 512;
    const int tid = C.tid, h = tid >> 7, vc = tid & 127;
    float S[K];
#pragma unroll
    for (int k = 0; k < K; ++k) S[k] = 0.f;
    bf16* P = (bf16*)(C.ws + WS_PROJ) + (size_t)b * SEQ * PW;
    const float* wa = C.in[I_GLAWA] + (size_t)l * 16 * 256; const float* ba = C.in[I_GLABA] + l * 256;
    constexpr int VOFF = GLA ? C_GV : C_HI, GOFF = GLA ? C_GG : C_HG;
    for (int t0 = 0; t0 < SEQ; t0 += TB) {
        for (int idx = tid; idx < TB * 4 * K; idx += NTHR) {
            const int tt = idx / (4 * K), hk = idx % (4 * K);
            const bf16* row = P + (size_t)(t0 + tt) * PW;
            float d, kv, qv;
            if (GLA) {
                float z = ba[hk];
#pragma unroll
                for (int j = 0; j < 16; ++j) z += bf2f(row[C_GA + j]) * wa[j * 256 + hk];
                const float ls = fminf(z, 0.f) - log1pf(expf(-fabsf(z)));
                d = expf(ls * (1.f / 16.f)); kv = bf2f(row[C_GK + hk]); qv = bf2f(row[C_GQ + hk]) * 0.125f;
            } else {
                const float z = bf2f(row[C_HF + hk]);
                float lb = 0.f; if (l == 1) { const float x0 = C.in[I_HGLB][hk], x1 = C.in[I_HGLB][512 + hk]; lb = 1.f / (1.f + expf(x0 - x1)); }
                const float sg = 1.f / (1.f + expf(-z)); d = fmaxf(lb + (1.f - lb) * sg, 1e-30f); kv = (1.f - lb) / (1.f + expf(z));
                const float q = bf2f(row[C_HQ + hk]); qv = q / (1.f + expf(-q)) * 0.08838834764831845f;
            }
            dec[idx] = d; kk[idx] = kv; qq[idx] = qv;
        }
        __syncthreads();
        for (int tt = 0; tt < TB; ++tt) {
            const float v = bf2f(P[(size_t)(t0 + tt) * PW + VOFF + tid]); float acc = 0.f;
            const LAS f32x4* dp = (const LAS f32x4*)(dec + (tt * 4 + h) * K); const LAS f32x4* kp = (const LAS f32x4*)(kk + (tt * 4 + h) * K); const LAS f32x4* qp = (const LAS f32x4*)(qq + (tt * 4 + h) * K);
#pragma unroll
            for (int k4 = 0; k4 < K / 4; ++k4) { const f32x4 d4 = dp[k4], kv4 = kp[k4], q4 = qp[k4];
#pragma unroll
                for (int i = 0; i < 4; ++i) { S[4 * k4 + i] = S[4 * k4 + i] * d4[i] + kv4[i] * v; acc += S[4 * k4 + i] * q4[i]; } }
            ob[tt * 512 + tid] = acc;
        }
        __syncthreads();
        if (tid < TB * 4) { const LAS float* o = ob + (tid >> 2) * 512 + (tid & 3) * 128; float s = 0.f; for (int i = 0; i < 128; ++i) s += o[i] * o[i]; part[tid] = s; }
        __syncthreads();
        for (int tt = 0; tt < TB; ++tt) {
            bf16* row = P + (size_t)(t0 + tt) * PW; const float o = ob[tt * 512 + tid]; const float g = bf2f(row[GOFF + tid]); float y;
            if (GLA) { const float r = 1.f / sqrtf(part[tt * 4 + h] * (1.f / 128.f) + RMS_EPS); y = o * r * C.in[I_GLANW][l * 128 + vc] * (g / (1.f + expf(-g))); }
            else { const float r = 1.f / sqrtf((part[tt * 4] + part[tt * 4 + 1] + part[tt * 4 + 2] + part[tt * 4 + 3]) * (1.f / 512.f) + RMS_EPS); y = o * r * C.in[I_HGNW][l * 512 + tid] / (1.f + expf(-g)); }
            row[VOFF + tid] = (bf16)f2bf(y);
        }
        __syncthreads();
    }
}

__device__ __forceinline__ void rg_pass1_naive(Ctx& C, int l, int c0, int cstride) {
    LAS float* cs = (LAS float*)C.lds;
    const int ch = C.tid, g = ch >> 6, jj = ch & 63;
    const bf16* P = (const bf16*)(C.ws + WS_PROJ);
    float* Ao = (float*)(C.ws + WS_RGA); float* Bo = (float*)(C.ws + WS_RGB);
    const float cw0 = C.in[I_CONVW][(l * 4 + 0) * 512 + ch], cw1 = C.in[I_CONVW][(l * 4 + 1) * 512 + ch], cw2 = C.in[I_CONVW][(l * 4 + 2) * 512 + ch], cw3 = C.in[I_CONVW][(l * 4 + 3) * 512 + ch];
    const float cb = C.in[I_CONVB][l * 512 + ch], br = C.in[I_RGBR][l * 512 + ch], bi = C.in[I_RGBI][l * 512 + ch], lam = C.in[I_RGLAM][l * 512 + ch];
    const float xs = -lam, sp = fmaxf(xs, 0.f) + log1pf(expf(-fabsf(xs)));
    const float* wr = C.in[I_RGWR] + ((size_t)(l * 8 + g) * 64) * 64 + jj; const float* wi = C.in[I_RGWI] + ((size_t)(l * 8 + g) * 64) * 64 + jj;
    for (int it = c0; it < T / 8; it += cstride) {
        const int b = it / (SEQ / 8), t0 = (it % (SEQ / 8)) * 8;
        float u[11];
#pragma unroll
        for (int j = 0; j < 11; ++j) { const int tt = t0 - 3 + j; u[j] = tt >= 0 ? bf2f(P[((size_t)b * SEQ + tt) * PW + C_RGX + ch]) : 0.f; }
        float cv[8];
#pragma unroll
        for (int tt = 0; tt < 8; ++tt) { cv[tt] = cb + u[tt] * cw0 + u[tt + 1] * cw1 + u[tt + 2] * cw2 + u[tt + 3] * cw3; cs[tt * 512 + ch] = cv[tt]; }
        __syncthreads();
        float ar[8], ai[8];
#pragma unroll
        for (int tt = 0; tt < 8; ++tt) { ar[tt] = br; ai[tt] = bi; }
        for (int i = 0; i < 64; ++i) { const float w_r = wr[i * 64], w_i = wi[i * 64];
#pragma unroll
            for (int tt = 0; tt < 8; ++tt) { const float c = cs[tt * 512 + g * 64 + i]; ar[tt] += c * w_r; ai[tt] += c * w_i; } }
#pragma unroll
        for (int tt = 0; tt < 8; ++tt) { const float r = 1.f / (1.f + expf(-ar[tt])), ig = 1.f / (1.f + expf(-ai[tt]));
            const float la = -8.f * r * sp; const float a = expf(la); const float bb = sqrtf(fmaxf(-expm1f(2.f * la), 0.f)) * (ig * cv[tt]);
            const size_t o = ((size_t)b * SEQ + t0 + tt) * 512 + ch; Ao[o] = a; Bo[o] = bb; }
        __syncthreads();
    }
}
__device__ __forceinline__ void rg_pass2_naive(Ctx& C, int b) {
    const int ch = C.tid; bf16* P = (bf16*)(C.ws + WS_PROJ) + (size_t)b * SEQ * PW;
    const float* Ao = (const float*)(C.ws + WS_RGA) + (size_t)b * SEQ * 512; const float* Bo = (const float*)(C.ws + WS_RGB) + (size_t)b * SEQ * 512;
    float h = 0.f;
    for (int t = 0; t < SEQ; t += 8) { float a[8], bb[8];
#pragma unroll
        for (int j = 0; j < 8; ++j) { a[j] = Ao[(size_t)(t + j) * 512 + ch]; bb[j] = Bo[(size_t)(t + j) * 512 + ch]; }
#pragma unroll
        for (int j = 0; j < 8; ++j) { h = a[j] * h + bb[j]; P[(size_t)(t + j) * PW + C_RGX + ch] = (bf16)f2bf(h); } }
}


template <bool FINAL>
__device__ __forceinline__ void rg_unit(Ctx& C, int l, int unit) {
    const int b = unit >> 8, j = unit & 255;
    const int g = C.wave, lane = C.lane, q = lane >> 4, r16 = lane & 15, ch = g * 64 + lane;
    LAS unsigned char* wl = C.lds + C.wave * 12288;
    LAS bf16* cbuf = (LAS bf16*)wl;
    LAS float* gr = (LAS float*)(wl + 2304);
    LAS float* gi = gr + 16 * 65;
    const bf16* wt = (const bf16*)(C.ws + WS_RGW) + ((size_t)(l * 2) * 8 + g) * 4096;
    bf16x8 Br[4][2], Bi[4][2];
#pragma unroll
    for (int n = 0; n < 4; ++n)
#pragma unroll
        for (int ks = 0; ks < 2; ++ks) { Br[n][ks] = *(const bf16x8*)(wt + (16 * n + r16) * 64 + 32 * ks + 8 * q); Bi[n][ks] = *(const bf16x8*)(wt + 8 * 4096 + (16 * n + r16) * 64 + 32 * ks + 8 * q); }
    const float cw0 = C.in[I_CONVW][(l * 4 + 0) * 512 + ch], cw1 = C.in[I_CONVW][(l * 4 + 1) * 512 + ch], cw2 = C.in[I_CONVW][(l * 4 + 2) * 512 + ch], cw3 = C.in[I_CONVW][(l * 4 + 3) * 512 + ch];
    const float cb = C.in[I_CONVB][l * 512 + ch], br = C.in[I_RGBR][l * 512 + ch], bi = C.in[I_RGBI][l * 512 + ch];
    const float xs = -C.in[I_RGLAM][l * 512 + ch], sp8 = 8.f * (fmaxf(xs, 0.f) + log1pf(expf(-fabsf(xs))));
    bf16* P = (bf16*)(C.ws + WS_PROJ) + ((size_t)b * SEQ + (size_t)j * 64) * PW + C_RGX + ch;
    bf16* halo = (bf16*)(C.ws + WS_RGHALO) + ((size_t)(b * 256 + j) * 3) * 512 + ch;
    float x3 = 0.f, x2 = 0.f, x1 = 0.f;
    if (j > 0) {
        if (FINAL) { x3 = bf2f(halo[0]); x2 = bf2f(halo[512]); x1 = bf2f(halo[1024]); }
        else { const bf16 h3 = P[-3 * (ptrdiff_t)PW], h2 = P[-2 * (ptrdiff_t)PW], h1 = P[-(ptrdiff_t)PW]; halo[0] = h3; halo[512] = h2; halo[1024] = h1; x3 = bf2f(h3); x2 = bf2f(h2); x1 = bf2f(h1); }
    }
    const size_t so = (size_t)(b * 256 + j) * 512 + ch;
    float h = FINAL ? ((const float*)(C.ws + WS_RGCARRY))[so] : 0.f, pp = 1.f;
    for (int m = 0; m < 4; ++m) {
        float cv[16];
#pragma unroll
        for (int i = 0; i < 16; ++i) { const float x0 = bf2f(P[(size_t)(16 * m + i) * PW]); cv[i] = cb + x3 * cw0 + x2 * cw1 + x1 * cw2 + x0 * cw3; x3 = x2; x2 = x1; x1 = x0;
            cbuf[i * 72 + lane] = (bf16)f2bf(cv[i]); }
        LDS_WAIT(); asm volatile("" ::: "memory");
        const bf16x8 a0 = *(const LAS bf16x8*)(cbuf + r16 * 72 + 8 * q), a1 = *(const LAS bf16x8*)(cbuf + r16 * 72 + 32 + 8 * q);
#pragma unroll
        for (int n = 0; n < 4; ++n) { f32x4 ar = (f32x4){0.f, 0.f, 0.f, 0.f}, ai = ar;
            ar = __builtin_amdgcn_mfma_f32_16x16x32_bf16(a0, Br[n][0], ar, 0, 0, 0); ar = __builtin_amdgcn_mfma_f32_16x16x32_bf16(a1, Br[n][1], ar, 0, 0, 0);
            ai = __builtin_amdgcn_mfma_f32_16x16x32_bf16(a0, Bi[n][0], ai, 0, 0, 0); ai = __builtin_amdgcn_mfma_f32_16x16x32_bf16(a1, Bi[n][1], ai, 0, 0, 0);
#pragma unroll
            for (int r = 0; r < 4; ++r) { gr[(4 * q + r) * 65 + 16 * n + r16] = ar[r]; gi[(4 * q + r) * 65 + 16 * n + r16] = ai[r]; } }
        LDS_WAIT(); asm volatile("" ::: "memory");
#pragma unroll
        for (int i = 0; i < 16; ++i) { const float rp = gr[i * 65 + lane] + br, ip = gi[i * 65 + lane] + bi;
            const float r = 1.f / (1.f + __expf(-rp)), ig = 1.f / (1.f + __expf(-ip));
            const float a = __expf(-r * sp8); const float bb = sqrtf(fmaxf(1.f - a * a, 0.f)) * (ig * cv[i]);
            h = a * h + bb;
            if (FINAL) P[(size_t)(16 * m + i) * PW] = (bf16)f2bf(h); else pp *= a; }
        LDS_WAIT(); asm volatile("" ::: "memory");
    }
    if (!FINAL) { ((float*)(C.ws + WS_RGSP))[so] = pp; ((float*)(C.ws + WS_RGSH))[so] = h; }
}
__device__ __forceinline__ void rg_carry(Ctx& C, int b) {
    const float* sp = (const float*)(C.ws + WS_RGSP) + (size_t)b * 256 * 512 + C.tid; const float* sh = (const float*)(C.ws + WS_RGSH) + (size_t)b * 256 * 512 + C.tid;
    float* cr = (float*)(C.ws + WS_RGCARRY) + (size_t)b * 256 * 512 + C.tid;
    float c = 0.f;
    for (int j = 0; j < 256; j += 8) { float p[8], hh[8];
#pragma unroll
        for (int i = 0; i < 8; ++i) { p[i] = sp[(size_t)(j + i) * 512]; hh[i] = sh[(size_t)(j + i) * 512]; }
#pragma unroll
        for (int i = 0; i < 8; ++i) { cr[(size_t)(j + i) * 512] = c; c = p[i] * c + hh[i]; } }
}

constexpr size_t WS_LALG_G = 402 * MiB;
constexpr size_t WS_LALG_H = WS_LALG_G + 512 * 1024;
constexpr size_t WS_LAU_G = 404 * MiB;
constexpr size_t WS_LAU_H = 420 * MiB;
constexpr size_t WS_SSQ = 524 * MiB;
typedef short s16x4 __attribute__((ext_vector_type(4)));
__device__ __forceinline__ bf16x8 cat8(s16x4 a, s16x4 b) { return __builtin_shufflevector(a, b, 0, 1, 2, 3, 4, 5, 6, 7); }
__device__ __forceinline__ bf16x8 pack8(f32x4 a, f32x4 b) { v4u w; w.x = pg8::cvt_pk_bf16(a[0], a[1]); w.y = pg8::cvt_pk_bf16(a[2], a[3]); w.z = pg8::cvt_pk_bf16(b[0], b[1]); w.w = pg8::cvt_pk_bf16(b[2], b[3]); return __builtin_bit_cast(bf16x8, w); }

template <int K, bool GLA, bool FINAL>
__device__ __forceinline__ void la_unit(Ctx& C, int l, int unit) {
    constexpr int KP = K + 8, TP = 72, NMT = K / 16, NKS = K / 32;
    constexpr int QT_OFF = 0, KT_OFF = QT_OFF + 64 * KP * 2, KH_OFF = KT_OFF + 64 * KP * 2, VT_OFF = KH_OFF + K * TP * 2, GM_OFF = VT_OFF + 128 * TP * 2, OB_OFF = GM_OFF + 2 * K * 4;
    constexpr int OBP = 132;
    static_assert(OB_OFF + 64 * OBP * 4 <= RING_BYTES, "la_unit LDS");
    const int b = unit >> 8, h = (unit >> 6) & 3, seg = unit & 63, bh = b * 4 + h;
    const int tid = C.tid, lane = C.lane, w = C.wave, q = lane >> 4, r16 = lane & 15;
    LAS unsigned char* L = C.lds;
    LAS bf16* QT = (LAS bf16*)(L + QT_OFF); LAS bf16* KT = (LAS bf16*)(L + KT_OFF); LAS bf16* KH = (LAS bf16*)(L + KH_OFF); LAS bf16* VT = (LAS bf16*)(L + VT_OFF);
    LAS float* GM = (LAS float*)(L + GM_OFF); LAS float* OB = (LAS float*)(L + OB_OFF);
    bf16* P = (bf16*)(C.ws + WS_PROJ) + ((size_t)b * SEQ + (size_t)seg * 256) * PW;
    constexpr int C_Q = GLA ? C_GQ : C_HQ, C_KK = GLA ? C_GK : C_HF, C_V = GLA ? C_GV : C_HI, C_G = GLA ? C_GG : C_HG;
    float* Ug = (float*)(C.ws + (GLA ? WS_LAU_G : WS_LAU_H)) + ((size_t)bh * 64 + seg) * (K * 128);
    float* LG = (float*)(C.ws + (GLA ? WS_LALG_G : WS_LALG_H)) + ((size_t)bh * 64 + seg) * (2 * K);
    const bool cum = tid < 2 * K; const int pblk = tid / K, pk = tid % K, hk = h * K + pk;
    float wa[16], ba = 0.f, lb = 0.f;
    if (GLA) {
#pragma unroll
        for (int j = 0; j < 16; ++j) wa[j] = cum ? C.in[I_GLAWA][(size_t)l * 16 * 256 + j * 256 + hk] : 0.f;
        ba = cum ? C.in[I_GLABA][l * 256 + hk] : 0.f;
    } else { if (l == 1 && cum) { const float x0 = C.in[I_HGLB][hk], x1 = C.in[I_HGLB][512 + hk]; lb = 1.f / (1.f + __expf(x0 - x1)); } }
    float gsum = 0.f;
    f32x4 S[NMT];
#pragma unroll
    for (int mt = 0; mt < NMT; ++mt) {
        if (FINAL) {
#pragma unroll
            for (int r = 0; r < 4; ++r) S[mt][r] = Ug[(size_t)(16 * mt + 4 * q + r) * 128 + 16 * w + r16];
        } else S[mt] = (f32x4){0.f, 0.f, 0.f, 0.f};
    }
    for (int grp = 0; grp < 4; ++grp) {
        bf16* Pg = P + (size_t)grp * 64 * PW;
        if (cum) {
            float Gs[32], ks[32], G = 0.f;
            const bf16* row = Pg + (size_t)pblk * 32 * PW;
#pragma unroll
            for (int s = 0; s < 32; ++s) {
                float lg, kv, qv;
                if (GLA) {
                    float z = ba; const v4u a0 = *(const v4u*)(row + C_GA), a1 = *(const v4u*)(row + C_GA + 8);
                    z += bflo(a0.x) * wa[0] + bfhi(a0.x) * wa[1] + bflo(a0.y) * wa[2] + bfhi(a0.y) * wa[3] + bflo(a0.z) * wa[4] + bfhi(a0.z) * wa[5] + bflo(a0.w) * wa[6] + bfhi(a0.w) * wa[7];
                    z += bflo(a1.x) * wa[8] + bfhi(a1.x) * wa[9] + bflo(a1.y) * wa[10] + bfhi(a1.y) * wa[11] + bflo(a1.z) * wa[12] + bfhi(a1.z) * wa[13] + bflo(a1.w) * wa[14] + bfhi(a1.w) * wa[15];
                    lg = (fminf(z, 0.f) - __logf(1.f + __expf(-fabsf(z)))) * (1.f / 16.f);
                    kv = bf2f(row[C_KK + hk]); qv = bf2f(row[C_Q + hk]) * 0.125f;
                } else {
                    const float z = bf2f(row[C_KK + hk]); const float e = __expf(-fabsf(z)), sp = 1.f / (1.f + e);
                    const float sg = z >= 0.f ? sp : e * sp, sgn = z >= 0.f ? e * sp : sp;
                    lg = __logf(fmaxf(lb + (1.f - lb) * sg, 1e-30f)); kv = (1.f - lb) * sgn;
                    const float qq = bf2f(row[C_Q + hk]); qv = qq / (1.f + __expf(-qq)) * 0.08838834764831845f;
                }
                G += lg; Gs[s] = G; ks[s] = kv;
                QT[(pblk * 32 + s) * KP + pk] = (bf16)f2bf(qv * __expf(G));
                KT[(pblk * 32 + s) * KP + pk] = (bf16)f2bf(kv * __expf(fminf(-G, 80.f)));
                row += PW;
            }
            gsum += G; GM[pblk * K + pk] = __expf(G);
            v4u o4[4];
#pragma unroll
            for (int s4 = 0; s4 < 4; ++s4) { float e[8];
#pragma unroll
                for (int i = 0; i < 8; ++i) e[i] = ks[8 * s4 + i] * __expf(G - Gs[8 * s4 + i]);
                o4[s4].x = pk2(e[0], e[1]); o4[s4].y = pk2(e[2], e[3]); o4[s4].z = pk2(e[4], e[5]); o4[s4].w = pk2(e[6], e[7]); }
#pragma unroll
            for (int s4 = 0; s4 < 4; ++s4) *(LAS v4u*)(KH + pk * TP + pblk * 32 + 8 * s4) = o4[s4];
        } else {
            constexpr int NV = NTHR - 2 * K;
            for (int idx = tid - 2 * K; idx < 64 * 64; idx += NV) { const int tok = idx >> 6, vp = idx & 63;
                const unsigned vv = *(const unsigned*)(Pg + (size_t)tok * PW + C_V + h * 128 + 2 * vp);
                VT[(2 * vp) * TP + tok] = (bf16)(vv & 0xffffu); VT[(2 * vp + 1) * TP + tok] = (bf16)(vv >> 16); }
        }
        __syncthreads();
#pragma unroll
        for (int blk = 0; blk < 2; ++blk) {
            if (FINAL) {
                f32x4 p00 = (f32x4){0.f, 0.f, 0.f, 0.f}, p01 = p00, p11 = p00;
                f32x4 o[2] = {p00, p00};
#pragma unroll
                for (int ks = 0; ks < NKS; ++ks) {
                    const bf16x8 kt0 = *(const LAS bf16x8*)(KT + (blk * 32 + r16) * KP + 32 * ks + 8 * q), kt1 = *(const LAS bf16x8*)(KT + (blk * 32 + 16 + r16) * KP + 32 * ks + 8 * q);
                    const bf16x8 qn0 = *(const LAS bf16x8*)(QT + (blk * 32 + r16) * KP + 32 * ks + 8 * q), qn1 = *(const LAS bf16x8*)(QT + (blk * 32 + 16 + r16) * KP + 32 * ks + 8 * q);
                    p00 = __builtin_amdgcn_mfma_f32_16x16x32_bf16(kt0, qn0, p00, 0, 0, 0);
                    p01 = __builtin_amdgcn_mfma_f32_16x16x32_bf16(kt0, qn1, p01, 0, 0, 0);
                    p11 = __builtin_amdgcn_mfma_f32_16x16x32_bf16(kt1, qn1, p11, 0, 0, 0);
                    const bf16x8 sa = pack8(S[2 * ks], S[2 * ks + 1]);
                    const bf16x8 qp0 = cat8(*(const LAS s16x4*)(QT + (blk * 32 + r16) * KP + 32 * ks + 4 * q), *(const LAS s16x4*)(QT + (blk * 32 + r16) * KP + 32 * ks + 16 + 4 * q));
                    const bf16x8 qp1 = cat8(*(const LAS s16x4*)(QT + (blk * 32 + 16 + r16) * KP + 32 * ks + 4 * q), *(const LAS s16x4*)(QT + (blk * 32 + 16 + r16) * KP + 32 * ks + 16 + 4 * q));
                    o[0] = __builtin_amdgcn_mfma_f32_16x16x32_bf16(sa, qp0, o[0], 0, 0, 0);
                    o[1] = __builtin_amdgcn_mfma_f32_16x16x32_bf16(sa, qp1, o[1], 0, 0, 0);
                }
#pragma unroll
                for (int r = 0; r < 4; ++r) { const bool keep = (4 * q + r) <= r16; p00[r] = keep ? p00[r] : 0.f; p11[r] = keep ? p11[r] : 0.f; }
                const f32x4 z4 = (f32x4){0.f, 0.f, 0.f, 0.f};
                const bf16x8 pb0 = pack8(p00, z4), pb1 = pack8(p01, p11);
                const bf16x8 va = cat8(*(const LAS s16x4*)(VT + (16 * w + r16) * TP + blk * 32 + 4 * q), *(const LAS s16x4*)(VT + (16 * w + r16) * TP + blk * 32 + 16 + 4 * q));
                o[0] = __builtin_amdgcn_mfma_f32_16x16x32_bf16(va, pb0, o[0], 0, 0, 0);
                o[1] = __builtin_amdgcn_mfma_f32_16x16x32_bf16(va, pb1, o[1], 0, 0, 0);
#pragma unroll
                for (int ct = 0; ct < 2; ++ct)
#pragma unroll
                    for (int r = 0; r < 4; ++r) OB[(blk * 32 + 16 * ct + r16) * OBP + 16 * w + 4 * q + r] = o[ct][r];
            }
            const bf16x8 vb = *(const LAS bf16x8*)(VT + (16 * w + r16) * TP + blk * 32 + 8 * q);
#pragma unroll
            for (int mt = 0; mt < NMT; ++mt) {
                const f32x4 gm = *(const LAS f32x4*)(GM + blk * K + 16 * mt + 4 * q);
                const bf16x8 ka = *(const LAS bf16x8*)(KH + (16 * mt + r16) * TP + blk * 32 + 8 * q);
                S[mt] = __builtin_amdgcn_mfma_f32_16x16x32_bf16(ka, vb, S[mt] * gm, 0, 0, 0);
            }
        }
        __syncthreads();
        if (FINAL) {
#pragma unroll 2
            for (int tk = 0; tk < 8; ++tk) { const int tok = 8 * w + tk; bf16* row = Pg + (size_t)tok * PW;
                const float o0 = OB[tok * OBP + 2 * lane], o1 = OB[tok * OBP + 2 * lane + 1];
                const float ssq = wave_sum_l(o0 * o0 + o1 * o1, lane);
                const unsigned gv = *(const unsigned*)(row + C_G + h * 128 + 2 * lane); const float g0 = bflo(gv), g1 = bfhi(gv);
                float y0, y1;
                if (GLA) { const float rs = 1.f / sqrtf(ssq * (1.f / 128.f) + RMS_EPS); const float n0 = C.in[I_GLANW][l * 128 + 2 * lane], n1 = C.in[I_GLANW][l * 128 + 2 * lane + 1];
                    y0 = o0 * rs * n0 * (g0 / (1.f + __expf(-g0))); y1 = o1 * rs * n1 * (g1 / (1.f + __expf(-g1))); }
                else { const float n0 = C.in[I_HGNW][l * 512 + h * 128 + 2 * lane], n1 = C.in[I_HGNW][l * 512 + h * 128 + 2 * lane + 1];
                    y0 = o0 * n0 / (1.f + __expf(-g0)); y1 = o1 * n1 / (1.f + __expf(-g1));
                    if (lane == 0) ((float*)(C.ws + WS_SSQ))[((size_t)b * SEQ + (size_t)seg * 256 + grp * 64 + tok) * 4 + h] = ssq; }
                *(unsigned*)(row + C_V + h * 128 + 2 * lane) = pk2(y0, y1); }
            __syncthreads();
        }
    }
    if (!FINAL) {
#pragma unroll
        for (int mt = 0; mt < NMT; ++mt)
#pragma unroll
            for (int r = 0; r < 4; ++r) Ug[(size_t)(16 * mt + 4 * q + r) * 128 + 16 * w + r16] = S[mt][r];
        if (cum) LG[pblk * K + pk] = gsum;
    }
}
template <int K, bool GLA>
__device__ __forceinline__ void la_scan(Ctx& C, int e) {
    const int bh = e / (K * 128), kv = e % (K * 128), k = kv >> 7;
    float* U = (float*)(C.ws + (GLA ? WS_LAU_G : WS_LAU_H)) + (size_t)bh * 64 * (K * 128) + kv;
    const float* LG = (const float*)(C.ws + (GLA ? WS_LALG_G : WS_LALG_H)) + (size_t)bh * 64 * (2 * K) + k;
    float S = 0.f;
    for (int s = 0; s < 64; s += 8) { float u[8], gm[8];
#pragma unroll
        for (int i = 0; i < 8; ++i) { u[i] = U[(size_t)(s + i) * (K * 128)]; gm[i] = __expf(LG[(s + i) * 2 * K] + LG[(s + i) * 2 * K + K]); }
#pragma unroll
        for (int i = 0; i < 8; ++i) { U[(size_t)(s + i) * (K * 128)] = S; S = gm[i] * S + u[i]; } }
}
__device__ __forceinline__ void phase_router(Ctx& C) {
    LAS float* rw = (LAS float*)C.lds;
    LAS int* lcnt = (LAS int*)(C.lds + 32768);
    LAS int* lbase = lcnt + 8;
    LAS int* rec = lcnt + 16;
    LAS float* recp = (LAS float*)(rec + 512);
    unsigned* gcnt = C.ctl + CW_MOECNT;
    int* tokof = (int*)(C.ws + WS_TOKOF); float* wof = (float*)(C.ws + WS_WOF);
    for (int i = C.tid; i < 8192; i += NTHR) rw[i] = C.in[I_ROUTER][i];
    for (int grp = C.cu; grp < T / 128; grp += C.G) {
        if (C.tid < 8) lcnt[C.tid] = 0;
        __syncthreads();
        for (int q = 0; q < 16; ++q) {
            const int tl = C.wave * 16 + q, m = grp * 128 + tl;
            const f32x4* xr = (const f32x4*)(C.R + (size_t)m * DM) + C.lane;
            float lg[8];
#pragma unroll
            for (int e = 0; e < 8; ++e) lg[e] = 0.f;
#pragma unroll
            for (int j = 0; j < 4; ++j) { const f32x4 v = xr[64 * j];
#pragma unroll
                for (int i = 0; i < 4; ++i) { const int k = 4 * (C.lane + 64 * j) + i; const f32x4 w0 = *(const LAS f32x4*)(rw + k * 8), w1 = *(const LAS f32x4*)(rw + k * 8 + 4);
                    lg[0] += v[i] * w0[0]; lg[1] += v[i] * w0[1]; lg[2] += v[i] * w0[2]; lg[3] += v[i] * w0[3]; lg[4] += v[i] * w1[0]; lg[5] += v[i] * w1[1]; lg[6] += v[i] * w1[2]; lg[7] += v[i] * w1[3]; } }
#pragma unroll
            for (int e = 0; e < 8; ++e) lg[e] = wave_sum_l(lg[e], C.lane);
            if (C.lane == 0) {
                int e0 = 0; float l0 = lg[0];
#pragma unroll
                for (int e = 1; e < 8; ++e) if (lg[e] > l0) { l0 = lg[e]; e0 = e; }
                int e1 = -1; float l1 = -3.0e38f;
#pragma unroll
                for (int e = 0; e < 8; ++e) if (e != e0 && lg[e] > l1) { l1 = lg[e]; e1 = e; }
                const float p0 = 1.f / (1.f + expf(l1 - l0));
                const int pos0 = __hip_atomic_fetch_add(&lcnt[e0], 1, __ATOMIC_RELAXED, __HIP_MEMORY_SCOPE_WORKGROUP), pos1 = __hip_atomic_fetch_add(&lcnt[e1], 1, __ATOMIC_RELAXED, __HIP_MEMORY_SCOPE_WORKGROUP);
                rec[tl * 4 + 0] = e0; rec[tl * 4 + 1] = pos0; rec[tl * 4 + 2] = e1; rec[tl * 4 + 3] = pos1; recp[tl * 2] = p0; recp[tl * 2 + 1] = 1.f - p0;
            }
        }
        __syncthreads();
        if (C.tid < 8) lbase[C.tid] = (int)__hip_atomic_fetch_add(gcnt + C.tid, (unsigned)lcnt[C.tid], RLX_AGENT);
        __syncthreads();
        if (C.tid < 128) { const int m = grp * 128 + C.tid; const int e0 = rec[C.tid * 4], p0 = rec[C.tid * 4 + 1], e1 = rec[C.tid * 4 + 2], p1 = rec[C.tid * 4 + 3];
            tokof[e0 * T + lbase[e0] + p0] = m * 2; wof[e0 * T + lbase[e0] + p0] = recp[C.tid * 2];
            tokof[e1 * T + lbase[e1] + p1] = m * 2 + 1; wof[e1 * T + lbase[e1] + p1] = recp[C.tid * 2 + 1]; }
        __syncthreads();
    }
}
__device__ __forceinline__ int moe_build_table(Ctx& C) {
    LAS int* tab = (LAS int*)(C.lds + MOETAB_OFF);
    if (C.tid == 0) { int p = 0;
        for (int e = 0; e < 8; ++e) { const int c = (int)__hip_atomic_load(C.ctl + CW_MOECNT + e, RLX_AGENT); const int np = (c + 255) >> 8;
            for (int j = 0; j < np && p < MOE_MAXP; ++j, ++p) { tab[p] = e; tab[MOE_MAXP + p] = j * 256; } }
        tab[2 * MOE_MAXP] = p; }
    __syncthreads();
    return tab[2 * MOE_MAXP];
}
__device__ __forceinline__ void phase_moe_gather(Ctx& C, int chunk, int NP) {
    const LAS int* tab = (const LAS int*)(C.lds + MOETAB_OFF);
    const int gw = C.cu * NWAVES + C.wave, NGW = C.G * NWAVES;
    const int* tokof = (const int*)(C.ws + WS_TOKOF); const float* wof = (const float*)(C.ws + WS_WOF);
    const bf16* x3b = (const bf16*)(C.ws + WS_X1B); bf16* xs = (bf16*)(C.ws + WS_XS);
    int* ent = (int*)(C.ws + WS_ENT); float* pw = (float*)(C.ws + WS_ENT) + 16384;
    const int pbase = chunk * MOE_CHUNK_PANELS; int np = NP - pbase; if (np > MOE_CHUNK_PANELS) np = MOE_CHUNK_PANELS; if (np < 0) np = 0;
    for (int r = gw; r < np * 256; r += NGW) {
        const int p = pbase + (r >> 8), e = tab[p], pos = tab[MOE_MAXP + p] + (r & 255);
        const int cnt = (int)__hip_atomic_load(C.ctl + CW_MOECNT + e, RLX_AGENT);
        int en = -1; float w = 0.f; if (pos < cnt) { en = tokof[e * T + pos]; w = wof[e * T + pos]; }
        v4u a = (v4u){0u, 0u, 0u, 0u}, b2 = a;
        if (en >= 0) { const v4u* src = (const v4u*)(x3b + (size_t)(en >> 1) * DM); a = src[C.lane]; b2 = src[64 + C.lane]; }
        v4u* dst = (v4u*)(xs + (size_t)r * DM); dst[C.lane] = a; dst[64 + C.lane] = b2;
        if (C.lane == 0) { ent[r] = en; pw[r] = w; }
    }
}


#if PROBE
constexpr int CW_CHK = 128;
__device__ __forceinline__ float dot_bf_f32col(const bf16* a, const float* W, int N, int col, int K, int lane) {
    float s = 0.f; for (int k = lane; k < K; k += 64) s += bf2f(a[k]) * W[(size_t)k * N + col]; return wave_sum(s); }
__device__ __forceinline__ void chk_flag(Ctx& C, int bit, float got, float exp_, float atol, float rtol) {
    if (!(fabsf(got - exp_) <= atol + rtol * fabsf(exp_))) { if (C.lane == 0) atomicOr(C.ctl + CW_CHK, 1u << bit); } }
__device__ __forceinline__ unsigned hsh(unsigned x) { x ^= x >> 16; x *= 0x7feb352du; x ^= x >> 15; x *= 0x846ca68bu; x ^= x >> 16; return x; }
__device__ __forceinline__ void phase_chk(Ctx& C, int which, int l) {
    const int gw = C.cu * NWAVES + C.wave;
    const bf16* XB = (const bf16*)(C.ws + WS_XB); const bf16* PROJ = (const bf16*)(C.ws + WS_PROJ); const bf16* X1B = (const bf16*)(C.ws + WS_X1B);
    const bf16* G0 = (const bf16*)(C.ws + WS_G0); const bf16* G1 = (const bf16*)(C.ws + WS_G1);
    float* save = (float*)(C.ws + WS_SMALL);
    if (gw >= 256) return;
    const unsigned h = hsh(gw * 7919u + which * 104729u + l * 31u + 12345u);
    const int t = (gw & 1) ? (int)(h % T) : ((gw >> 1) * 256 + (int)(h % 256)) % T;
    if (which == 0) { const int c = (int)((h >> 8) % 4112);
        int oc; if (c < 1536) oc = c; else if (c < 2048) oc = 1552 + (c - 1536); else if (c < 4096) oc = 2064 + (c - 2048); else oc = 1536 + (c - 4096);
        const float e = dot_bf_f32col(XB + (size_t)t * DM, C.in[I_WIN] + (size_t)l * DM * DIN, DIN, oc, DM, C.lane);
        chk_flag(C, 0, bf2f(PROJ[(size_t)t * PW + c]), e, 0.03f, 0.02f); }
    else if (which == 1) { const int c = (int)((h >> 8) % 3072); const int n = c >> 10, d = c & 1023;
        const float e = dot_bf_f32col(XB + (size_t)t * DM, C.in[I_WIN] + (size_t)l * DM * DIN, DIN, 4112 + c, DM, C.lane);
        const float g = n == 0 ? bf2f(G0[(size_t)t * 1024 + d]) : (n == 1 ? bf2f(G1[(size_t)t * 1024 + d]) : bf2f(PROJ[(size_t)t * PW + C_HQ + d]));
        chk_flag(C, 1, g, 1.f / (1.f + expf(-e)), 0.01f, 0.01f); }
    else if (which == 2) { const int d = (int)((h >> 8) % 1024); float e = 0.f;
        for (int n = 0; n < 3; ++n) { const int ycol = n == 0 ? C_RGX : (n == 1 ? C_GV : C_HI);
            const float g = n == 0 ? bf2f(G0[(size_t)t * 1024 + d]) : (n == 1 ? bf2f(G1[(size_t)t * 1024 + d]) : bf2f(PROJ[(size_t)t * PW + C_HQ + d]));
            e += g * dot_bf_f32col(PROJ + (size_t)t * PW + ycol, C.in[I_WBR] + (size_t)(l * 3 + n) * 512 * 1024, 1024, d, 512, C.lane); }
        chk_flag(C, 2, bf2f(XB[(size_t)t * DM + d]), e, 0.02f, 0.03f); }
    else if (which == 3) { if (l == 0) { const int d = (int)((h >> 8) % 1024);
        const float e = ALPHA * C.in[I_X][(size_t)t * DM + d] + dot_bf_f32col(XB + (size_t)t * DM, C.in[I_WOUT] + (size_t)l * DM * DM, DM, d, DM, C.lane);
        chk_flag(C, 3, C.R[(size_t)t * DM + d], e, 0.02f, 0.01f); } }
    else if (which == 4) { const int j = (int)((h >> 8) % DFF); const int d = (int)((h >> 4) % 1024);
        const float g = dot_bf_f32col(X1B + (size_t)t * DM, C.in[I_FFNWG], DFF, j, DM, C.lane), u = dot_bf_f32col(X1B + (size_t)t * DM, C.in[I_FFNWU], DFF, j, DM, C.lane);
        chk_flag(C, 4, bf2f(PROJ[(size_t)t * DFF + j]), g / (1.f + expf(-g)) * u, 0.03f, 0.03f);
        if (C.lane == 0) save[gw] = C.R[(size_t)t * DM + d]; }
    else if (which == 5) { const unsigned h4 = hsh(gw * 7919u + 4 * 104729u + l * 31u + 12345u); const int t4 = (gw & 1) ? (int)(h4 % T) : ((gw >> 1) * 256 + (int)(h4 % 256)) % T; const int d = (int)((h4 >> 4) % 1024);
        const float e = ALPHA * save[gw] + dot_bf_f32col(PROJ + (size_t)t4 * DFF, C.in[I_FFNWD], DM, d, DFF, C.lane);
        chk_flag(C, 5, C.R[(size_t)t4 * DM + d], e, 0.02f, 0.01f); }
    else if (which == 6) { if (gw < 64) {
        const int tt = (int)(hsh(gw * 977u + 5u) % T); const int d0 = (int)(hsh(gw * 131u + 9u) % 1024);
        float lg[8];
#pragma unroll
        for (int e = 0; e < 8; ++e) { float s = 0.f; for (int k = C.lane; k < DM; k += 64) s += C.R[(size_t)tt * DM + k] * C.in[I_ROUTER][k * 8 + e]; lg[e] = wave_sum(s); }
        int e0 = 0; float l0 = lg[0];
#pragma unroll
        for (int e = 1; e < 8; ++e) if (lg[e] > l0) { l0 = lg[e]; e0 = e; }
        int e1 = -1; float l1 = -3.0e38f;
#pragma unroll
        for (int e = 0; e < 8; ++e) if (e != e0 && lg[e] > l1) { l1 = lg[e]; e1 = e; }
        const float p0 = 1.f / (1.f + expf(l1 - l0));
        float f = 0.f;
        for (int s = 0; s < 2; ++s) { const int e = s ? e1 : e0; const float p = s ? 1.f - p0 : p0;
            const float* wg = C.in[I_MOEWG] + (size_t)e * DM * DFFE; const float* wu = C.in[I_MOEWU] + (size_t)e * DM * DFFE; const float* wd = C.in[I_MOEWD] + (size_t)e * DFFE * DM;
            float acc = 0.f;
            for (int j = C.lane; j < DFFE; j += 64) { float g = 0.f, u = 0.f;
                for (int k = 0; k < DM; ++k) { const float xv = bf2f(X1B[(size_t)tt * DM + k]); g += xv * wg[(size_t)k * DFFE + j]; u += xv * wu[(size_t)k * DFFE + j]; }
                acc += (g / (1.f + expf(-g)) * u) * wd[(size_t)j * DM + d0]; }
            f += p * wave_sum(acc); }
        const bf16* ys0 = (const bf16*)(C.ws + WS_YS0); const bf16* ys1 = (const bf16*)(C.ws + WS_YS1);
        chk_flag(C, 6, bf2f(ys0[(size_t)tt * DM + d0]) + bf2f(ys1[(size_t)tt * DM + d0]), f, 0.02f, 0.04f); } }
}
__device__ __forceinline__ void phase_chk_encode(Ctx& C) {
    const unsigned code = __hip_atomic_load(C.ctl + CW_CHK, RLX_AGENT);
    if (code == 0u) return;
    const float c = sqrtf((float)code);
    for (size_t i = (size_t)C.cu * NTHR + C.tid; i < (size_t)T * DM; i += (size_t)C.G * NTHR) C.R[i] = c;
}
#endif
__global__ void __launch_bounds__(NTHR, 2) mega(Args args) {
    extern __shared__ __attribute__((aligned(16))) unsigned char lds_raw[];
    Ctx C;
    C.lds = (LAS unsigned char*)lds_raw;
    C.tid = threadIdx.x; C.lane = C.tid & 63; C.wave = __builtin_amdgcn_readfirstlane(C.tid >> 6);
    const int wave_s = C.wave;
    C.G = gridDim.x; C.cu = blockIdx.x;
#define lo (*(const int __attribute__((address_space(4)))*)(ka + 232))
#define hi (*(const int __attribute__((address_space(4)))*)(ka + 236))
#define KLI (*(const int __attribute__((address_space(4)))*)(ka + 240))
    const kptr_t ka = (kptr_t)__builtin_amdgcn_kernarg_segment_ptr();
    C.in = (inptr_t)ka; C.ws = *(unsigned char* const __attribute__((address_space(4)))*)(ka + 224); C.ctl = (unsigned*)(C.ws + WS_CTL); C.R = *(float* const __attribute__((address_space(4)))*)(ka + 216);
    volatile LAS unsigned* MISC = (volatile LAS unsigned*)(C.lds + MISC_OFF);
    for (int u = C.tid; u < 64; u += NTHR) MISC[u] = 0u;
    __syncthreads();
#if MK_ONE_LAUNCH
    (void)xcd_barrier_post(C.ctl + CW_BAR + KLI * XCD_BAR_WORDS, MISC + 8);
#define SEAM() do { XcdBarrier _b; _b.bar = (unsigned*)(*(unsigned char* const __attribute__((address_space(4)))*)(ka + 224) + WS_CTL) + CW_BAR + KLI * XCD_BAR_WORDS; _b.x = xb_xcc_id(); _b.st = (volatile LAS unsigned*)(C.lds + MISC_OFF) + 8; xcd_barrier(_b); } while (0)
#else
#define SEAM() do { } while (0)
#endif
    int ph = 0;
#define IN_PH() (lo <= ph && ph < hi)
#ifndef PH_MASK
#define PH_MASK 0xffffffffu
#endif
#define EN(k) (((PH_MASK) >> (k)) & 1u)
#define PH_BEGIN() do { unsigned _m = ~0u; asm volatile("" : "+s"(_m)); int _t = wave_s * 64 + (int)__builtin_amdgcn_mbcnt_hi(_m, __builtin_amdgcn_mbcnt_lo(_m, 0u)); asm volatile("" : "+v"(_t)); C.tid = _t; C.lane = _t & 63; C.wave = __builtin_amdgcn_readfirstlane(_t >> 6); \
    kptr_t _k = ka; asm volatile("" : "+s"(_k)); C.in = (inptr_t)_k; C.ws = *(unsigned char* const __attribute__((address_space(4)))*)(_k + 224); C.ctl = (unsigned*)(C.ws + WS_CTL); \
    C.R = *(float* const __attribute__((address_space(4)))*)(_k + 216); } while (0)
#define NEXT_PH() do { if (lo <= ph && ph + 1 < hi) SEAM(); ++ph; } while (0)
    LAS unsigned char* ring = C.lds;
#define XB ((bf16*)(C.ws + WS_XB))
#define PROJ ((bf16*)(C.ws + WS_PROJ))
#define X1B ((bf16*)(C.ws + WS_X1B))
#define G0 ((bf16*)(C.ws + WS_G0))
#define G1 ((bf16*)(C.ws + WS_G1))

    if (IN_PH() && EN(0)) { PH_BEGIN(); phase_conv(C); }
    NEXT_PH();

    { constexpr int l = 0;
        if (IN_PH() && EN(1)) { PH_BEGIN(); pg8::Gemm g{XB, (const bf16*)(C.ws + WS_WINA) + (size_t)l * PW * DM, T, PW, DM, DM}; pg8::StaticOrder S; S.init(T, PW, C.G, C.cu);
            pg8::EpiBf16<0> E{PROJ, PW, nullptr, 0, 0, 1.f};
            pg8::gemm_phase<pg8::EpiBf16<0>, pg8::StaticOrder, true, true>(ring, g, S, E, C.tid); }
        NEXT_PH();
        #if PROBE
        if (IN_PH()) { PH_BEGIN(); phase_chk(C, 0, l); }
        NEXT_PH();
#endif
        if (IN_PH() && EN(2)) {   }
        NEXT_PH();
        if (IN_PH() && EN(3)) { PH_BEGIN();
            for (int u = C.cu; u < 512; u += C.G) la_unit<128, false, false>(C, l, u);
            PH_BEGIN();
            for (int u = C.cu; u < 512; u += C.G) la_unit<64, true, false>(C, l, u);
            PH_BEGIN();
            for (int u = C.cu; u < 512; u += C.G) rg_unit<false>(C, l, u); }
        NEXT_PH();
        if (IN_PH() && EN(3)) { PH_BEGIN();
            for (int e = C.cu * NTHR + C.tid; e < 8 * 128 * 128; e += C.G * NTHR) la_scan<128, false>(C, e);
            for (int e = C.cu * NTHR + C.tid; e < 8 * 64 * 128; e += C.G * NTHR) la_scan<64, true>(C, e);
            if (C.cu >= C.G - 2) rg_carry(C, C.cu - (C.G - 2)); }
        NEXT_PH();
        if (IN_PH() && EN(3)) { PH_BEGIN();
            for (int u = C.cu; u < 512; u += C.G) la_unit<128, false, true>(C, l, u);
            PH_BEGIN();
            for (int u = C.cu; u < 512; u += C.G) la_unit<64, true, true>(C, l, u);
            PH_BEGIN();
            for (int u = C.cu; u < 512; u += C.G) rg_unit<true>(C, l, u); }
        NEXT_PH();
        if (IN_PH() && EN(4)) { PH_BEGIN();
            for (int n = 0; n < 3; ++n) {
                pg8::Gemm g{XB, (const bf16*)(C.ws + WS_WGATE) + ((size_t)l * 3072 + n * 1024) * DM, T, 1024, DM, DM}; pg8::StaticOrder S; S.init(T, 1024, C.G, C.cu);
                bf16* gp = G0 + (size_t)n * ((WS_G1 - WS_G0) / 2); int ldg = 1024; if (n == 2) { gp = PROJ + C_HQ; ldg = PW; }
                pg8::EpiSig E{gp, ldg};
                pg8::gemm_phase<pg8::EpiSig, pg8::StaticOrder, true, true>(ring, g, S, E, C.tid);
                __syncthreads();
            } }
        NEXT_PH();
        #if PROBE
        if (IN_PH()) { PH_BEGIN(); phase_chk(C, 1, l); }
        NEXT_PH();
#endif
        if (IN_PH() && EN(5)) { PH_BEGIN();
            for (int n = 0; n < 3; ++n) {
#ifdef ABL_SKIP_BRANCH
                if (n == ABL_SKIP_BRANCH) continue;
#endif
                const int ycol = n * 1024 + (n == 2 ? 1024 : 0);
                pg8::Gemm g{PROJ + ycol, (const bf16*)(C.ws + WS_WBR) + (size_t)(l * 3 + n) * 1024 * 512, T, 1024, 512, PW}; pg8::StaticOrder S; S.init(T, 1024, C.G, C.cu);
                #ifdef ABL_SKIP_BRANCH
                const int firstn = ABL_SKIP_BRANCH == 0 ? 1 : 0;
#else
                const int firstn = 0;
#endif
                const bf16* gp = G0 + (size_t)n * ((WS_G1 - WS_G0) / 2); int ldg = 1024; if (n == 2) { gp = PROJ + C_HQ; ldg = PW; }
                pg8::EpiBranch E{gp, ldg, XB, n == firstn ? 1 : 0, n == 2 ? (const float*)(C.ws + WS_SSQ) : nullptr};
                pg8::gemm_phase<pg8::EpiBranch, pg8::StaticOrder, true, true>(ring, g, S, E, C.tid);
                __syncthreads();
            }
        }
        NEXT_PH();
        #if PROBE
        if (IN_PH()) { PH_BEGIN(); phase_chk(C, 2, l); }
        NEXT_PH();
#endif
        if (IN_PH() && EN(6)) { PH_BEGIN(); pg8::Gemm g{XB, (const bf16*)(C.ws + WS_WOUT) + (size_t)l * 1024 * 1024, T, 1024, 1024, 1024}; pg8::StaticOrder S; S.init(T, 1024, C.G, C.cu);
            pg8::EpiResid E{l == 0 ? C.in[I_X] : C.R, C.R, ALPHA};
            pg8::gemm_phase<pg8::EpiResid, pg8::StaticOrder, true, true>(ring, g, S, E, C.tid); }
        NEXT_PH();
        #if PROBE
        if (IN_PH()) { PH_BEGIN(); phase_chk(C, 3, l); }
        NEXT_PH();
#endif
        if (IN_PH() && EN(7)) { PH_BEGIN(); phase_ln<false>(C, C.in[I_LN1G] + l * DM, C.in[I_LN1B] + l * DM, X1B); }
        NEXT_PH();
        if (l == 0) {
            if (IN_PH() && EN(8)) { PH_BEGIN(); pg8::Gemm g{X1B, (const bf16*)(C.ws + WS_WGU), T, 2 * DFF, DM, DM}; pg8::StaticOrder S; S.init(T, 2 * DFF, C.G, C.cu);
                pg8::EpiSwiGLU E{PROJ, DFF};
                pg8::gemm_phase<pg8::EpiSwiGLU, pg8::StaticOrder, true, true>(ring, g, S, E, C.tid); }
            NEXT_PH();
            #if PROBE
            if (IN_PH()) { PH_BEGIN(); phase_chk(C, 4, l); }
            NEXT_PH();
#endif
            if (IN_PH() && EN(9)) { PH_BEGIN(); pg8::Gemm g{PROJ, (const bf16*)(C.ws + WS_WD), T, 1024, DFF, DFF}; pg8::StaticOrder S; S.init(T, 1024, C.G, C.cu);
                pg8::EpiResid E{C.R, C.R, ALPHA};
                pg8::gemm_phase<pg8::EpiResid, pg8::StaticOrder, true, true>(ring, g, S, E, C.tid); }
            NEXT_PH();
            #if PROBE
            if (IN_PH()) { PH_BEGIN(); phase_chk(C, 5, l); }
            NEXT_PH();
#endif
            if (IN_PH() && EN(10)) { PH_BEGIN(); phase_ln<false>(C, C.in[I_LN2G], C.in[I_LN2B], XB); }
            NEXT_PH();
        } else {
            if (IN_PH() && EN(11)) { PH_BEGIN(); phase_router(C); __syncthreads(); phase_conv_moe(C); }
            NEXT_PH();
            for (int ck = 0; ck < MOE_NCHUNK; ++ck) {
                int NP = 0;
                if (IN_PH() && EN(12)) { PH_BEGIN(); NP = moe_build_table(C); phase_moe_gather(C, ck, NP); }
                NEXT_PH();
                if (IN_PH() && EN(13)) { PH_BEGIN(); NP = moe_build_table(C); int np = NP - ck * MOE_CHUNK_PANELS; if (np > MOE_CHUNK_PANELS) np = MOE_CHUNK_PANELS;
                    if (np > 0) { pg8::Gemm g{(const bf16*)(C.ws + WS_XS), (const bf16*)(C.ws + WS_MWGU), 16384, 7168, DM, DM};
                        pg8::MoeOrder S{(const LAS int*)(C.lds + MOETAB_OFF), ck * MOE_CHUNK_PANELS, np, C.G, C.cu, 28, 28};
                        pg8::EpiSwiGLU E{(bf16*)(C.ws + WS_HC), DFFE};
                        pg8::gemm_phase<pg8::EpiSwiGLU, pg8::MoeOrder, true, true>(ring, g, S, E, C.tid); } }
                NEXT_PH();
                if (IN_PH() && EN(14)) { PH_BEGIN(); NP = moe_build_table(C); int np = NP - ck * MOE_CHUNK_PANELS; if (np > MOE_CHUNK_PANELS) np = MOE_CHUNK_PANELS;
                    if (np > 0) { pg8::Gemm g{(const bf16*)(C.ws + WS_HC), (const bf16*)(C.ws + WS_MWD), 16384, 1024, DFFE, DFFE};
                        pg8::MoeOrder S{(const LAS int*)(C.lds + MOETAB_OFF), ck * MOE_CHUNK_PANELS, np, C.G, C.cu, 4, 4};
                        pg8::EpiMoeDown E{(const int*)(C.ws + WS_ENT), (const float*)(C.ws + WS_ENT) + 16384, (bf16*)(C.ws + WS_YS0), (bf16*)(C.ws + WS_YS1)};
                        pg8::gemm_phase<pg8::EpiMoeDown, pg8::MoeOrder, true, true>(ring, g, S, E, C.tid); } }
                NEXT_PH();
            }
            #if PROBE
            if (IN_PH()) { PH_BEGIN(); phase_chk(C, 6, l); }
            NEXT_PH();
#endif
            if (IN_PH() && EN(15)) { PH_BEGIN(); phase_ln<true>(C, C.in[I_LN2G] + DM, C.in[I_LN2B] + DM, nullptr); }
            NEXT_PH();
        }
    }
    { constexpr int l = 1;
        if (IN_PH() && EN(1)) { PH_BEGIN(); pg8::Gemm g{XB, (const bf16*)(C.ws + WS_WINA) + (size_t)l * PW * DM, T, PW, DM, DM}; pg8::StaticOrder S; S.init(T, PW, C.G, C.cu);
            pg8::EpiBf16<0> E{PROJ, PW, nullptr, 0, 0, 1.f};
            pg8::gemm_phase<pg8::EpiBf16<0>, pg8::StaticOrder, true, true>(ring, g, S, E, C.tid); }
        NEXT_PH();
        #if PROBE
        if (IN_PH()) { PH_BEGIN(); phase_chk(C, 0, l); }
        NEXT_PH();
#endif
        if (IN_PH() && EN(2)) {   }
        NEXT_PH();
        if (IN_PH() && EN(3)) { PH_BEGIN();
            for (int u = C.cu; u < 512; u += C.G) la_unit<128, false, false>(C, l, u);
            PH_BEGIN();
            for (int u = C.cu; u < 512; u += C.G) la_unit<64, true, false>(C, l, u);
            PH_BEGIN();
            for (int u = C.cu; u < 512; u += C.G) rg_unit<false>(C, l, u); }
        NEXT_PH();
        if (IN_PH() && EN(3)) { PH_BEGIN();
            for (int e = C.cu * NTHR + C.tid; e < 8 * 128 * 128; e += C.G * NTHR) la_scan<128, false>(C, e);
            for (int e = C.cu * NTHR + C.tid; e < 8 * 64 * 128; e += C.G * NTHR) la_scan<64, true>(C, e);
            if (C.cu >= C.G - 2) rg_carry(C, C.cu - (C.G - 2)); }
        NEXT_PH();
        if (IN_PH() && EN(3)) { PH_BEGIN();
            for (int u = C.cu; u < 512; u += C.G) la_unit<128, false, true>(C, l, u);
            PH_BEGIN();
            for (int u = C.cu; u < 512; u += C.G) la_unit<64, true, true>(C, l, u);
            PH_BEGIN();
            for (int u = C.cu; u < 512; u += C.G) rg_unit<true>(C, l, u); }
        NEXT_PH();
        if (IN_PH() && EN(4)) { PH_BEGIN();
            for (int n = 0; n < 3; ++n) {
                pg8::Gemm g{XB, (const bf16*)(C.ws + WS_WGATE) + ((size_t)l * 3072 + n * 1024) * DM, T, 1024, DM, DM}; pg8::StaticOrder S; S.init(T, 1024, C.G, C.cu);
                bf16* gp = G0 + (size_t)n * ((WS_G1 - WS_G0) / 2); int ldg = 1024; if (n == 2) { gp = PROJ + C_HQ; ldg = PW; }
                pg8::EpiSig E{gp, ldg};
                pg8::gemm_phase<pg8::EpiSig, pg8::StaticOrder, true, true>(ring, g, S, E, C.tid);
                __syncthreads();
            } }
        NEXT_PH();
        #if PROBE
        if (IN_PH()) { PH_BEGIN(); phase_chk(C, 1, l); }
        NEXT_PH();
#endif
        if (IN_PH() && EN(5)) { PH_BEGIN();
            for (int n = 0; n < 3; ++n) {
#ifdef ABL_SKIP_BRANCH
                if (n == ABL_SKIP_BRANCH) continue;
#endif
                const int ycol = n * 1024 + (n == 2 ? 1024 : 0);
                pg8::Gemm g{PROJ + ycol, (const bf16*)(C.ws + WS_WBR) + (size_t)(l * 3 + n) * 1024 * 512, T, 1024, 512, PW}; pg8::StaticOrder S; S.init(T, 1024, C.G, C.cu);
                #ifdef ABL_SKIP_BRANCH
                const int firstn = ABL_SKIP_BRANCH == 0 ? 1 : 0;
#else
                const int firstn = 0;
#endif
                const bf16* gp = G0 + (size_t)n * ((WS_G1 - WS_G0) / 2); int ldg = 1024; if (n == 2) { gp = PROJ + C_HQ; ldg = PW; }
                pg8::EpiBranch E{gp, ldg, XB, n == firstn ? 1 : 0, n == 2 ? (const float*)(C.ws + WS_SSQ) : nullptr};
                pg8::gemm_phase<pg8::EpiBranch, pg8::StaticOrder, true, true>(ring, g, S, E, C.tid);
                __syncthreads();
            }
        }
        NEXT_PH();
        #if PROBE
        if (IN_PH()) { PH_BEGIN(); phase_chk(C, 2, l); }
        NEXT_PH();
#endif
        if (IN_PH() && EN(6)) { PH_BEGIN(); pg8::Gemm g{XB, (const bf16*)(C.ws + WS_WOUT) + (size_t)l * 1024 * 1024, T, 1024, 1024, 1024}; pg8::StaticOrder S; S.init(T, 1024, C.G, C.cu);
            pg8::EpiResid E{l == 0 ? C.in[I_X] : C.R, C.R, ALPHA};
            pg8::gemm_phase<pg8::EpiResid, pg8::StaticOrder, true, true>(ring, g, S, E, C.tid); }
        NEXT_PH();
        #if PROBE
        if (IN_PH()) { PH_BEGIN(); phase_chk(C, 3, l); }
        NEXT_PH();
#endif
        if (IN_PH() && EN(7)) { PH_BEGIN(); phase_ln<false>(C, C.in[I_LN1G] + l * DM, C.in[I_LN1B] + l * DM, X1B); }
        NEXT_PH();
        if (l == 0) {
            if (IN_PH() && EN(8)) { PH_BEGIN(); pg8::Gemm g{X1B, (const bf16*)(C.ws + WS_WGU), T, 2 * DFF, DM, DM}; pg8::StaticOrder S; S.init(T, 2 * DFF, C.G, C.cu);
                pg8::EpiSwiGLU E{PROJ, DFF};
                pg8::gemm_phase<pg8::EpiSwiGLU, pg8::StaticOrder, true, true>(ring, g, S, E, C.tid); }
            NEXT_PH();
            #if PROBE
            if (IN_PH()) { PH_BEGIN(); phase_chk(C, 4, l); }
            NEXT_PH();
#endif
            if (IN_PH() && EN(9)) { PH_BEGIN(); pg8::Gemm g{PROJ, (const bf16*)(C.ws + WS_WD), T, 1024, DFF, DFF}; pg8::StaticOrder S; S.init(T, 1024, C.G, C.cu);
                pg8::EpiResid E{C.R, C.R, ALPHA};
                pg8::gemm_phase<pg8::EpiResid, pg8::StaticOrder, true, true>(ring, g, S, E, C.tid); }
            NEXT_PH();
            #if PROBE
            if (IN_PH()) { PH_BEGIN(); phase_chk(C, 5, l); }
            NEXT_PH();
#endif
            if (IN_PH() && EN(10)) { PH_BEGIN(); phase_ln<false>(C, C.in[I_LN2G], C.in[I_LN2B], XB); }
            NEXT_PH();
        } else {
            if (IN_PH() && EN(11)) { PH_BEGIN(); phase_router(C); __syncthreads(); phase_conv_moe(C); }
            NEXT_PH();
            for (int ck = 0; ck < MOE_NCHUNK; ++ck) {
                int NP = 0;
                if (IN_PH() && EN(12)) { PH_BEGIN(); NP = moe_build_table(C); phase_moe_gather(C, ck, NP); }
                NEXT_PH();
                if (IN_PH() && EN(13)) { PH_BEGIN(); NP = moe_build_table(C); int np = NP - ck * MOE_CHUNK_PANELS; if (np > MOE_CHUNK_PANELS) np = MOE_CHUNK_PANELS;
                    if (np > 0) { pg8::Gemm g{(const bf16*)(C.ws + WS_XS), (const bf16*)(C.ws + WS_MWGU), 16384, 7168, DM, DM};
                        pg8::MoeOrder S{(const LAS int*)(C.lds + MOETAB_OFF), ck * MOE_CHUNK_PANELS, np, C.G, C.cu, 28, 28};
                        pg8::EpiSwiGLU E{(bf16*)(C.ws + WS_HC), DFFE};
                        pg8::gemm_phase<pg8::EpiSwiGLU, pg8::MoeOrder, true, true>(ring, g, S, E, C.tid); } }
                NEXT_PH();
                if (IN_PH() && EN(14)) { PH_BEGIN(); NP = moe_build_table(C); int np = NP - ck * MOE_CHUNK_PANELS; if (np > MOE_CHUNK_PANELS) np = MOE_CHUNK_PANELS;
                    if (np > 0) { pg8::Gemm g{(const bf16*)(C.ws + WS_HC), (const bf16*)(C.ws + WS_MWD), 16384, 1024, DFFE, DFFE};
                        pg8::MoeOrder S{(const LAS int*)(C.lds + MOETAB_OFF), ck * MOE_CHUNK_PANELS, np, C.G, C.cu, 4, 4};
                        pg8::EpiMoeDown E{(const int*)(C.ws + WS_ENT), (const float*)(C.ws + WS_ENT) + 16384, (bf16*)(C.ws + WS_YS0), (bf16*)(C.ws + WS_YS1)};
                        pg8::gemm_phase<pg8::EpiMoeDown, pg8::MoeOrder, true, true>(ring, g, S, E, C.tid); } }
                NEXT_PH();
            }
            #if PROBE
            if (IN_PH()) { PH_BEGIN(); phase_chk(C, 6, l); }
            NEXT_PH();
#endif
            if (IN_PH() && EN(15)) { PH_BEGIN(); phase_ln<true>(C, C.in[I_LN2G] + DM, C.in[I_LN2B] + DM, nullptr); }
            NEXT_PH();
        }
    }
#if PROBE
    if (IN_PH()) { PH_BEGIN(); phase_chk_encode(C); }
    NEXT_PH();
#endif
}

__global__ void __launch_bounds__(NTHR, 2) mix1_naive_kernel(Args args, int l) {
    extern __shared__ __attribute__((aligned(16))) unsigned char lds_raw[];
    Ctx C; C.lds = (LAS unsigned char*)lds_raw; C.tid = threadIdx.x; C.lane = C.tid & 63; C.wave = __builtin_amdgcn_readfirstlane(C.tid >> 6);
    C.G = gridDim.x; C.cu = blockIdx.x; C.ws = args.ws; C.ctl = (unsigned*)(args.ws + WS_CTL); C.R = args.out; C.in = (inptr_t)__builtin_amdgcn_kernarg_segment_ptr();
    if (C.cu < 2) mix_naive<64, true>(C, l, C.cu);
    else if (C.cu < 4) mix_naive<128, false>(C, l, C.cu - 2);
}
#undef lo
#undef hi
#undef KLI
#undef XB
#undef PROJ
#undef X1B
#undef G0
#undef G1
#if PROBE
constexpr int N_PHASES = 1 + (7 + 3) + (7 + 1 + 3 * MOE_NCHUNK + 1) + (4 + 2) + (4 + 1) + 1;
#else
constexpr int N_PHASES = 1 + (9 + 3) + (9 + 1 + 3 * MOE_NCHUNK + 1);
#endif

extern "C" void kernel_launch(void* const* d_in, const int* in_sizes, int n_in, void* d_out, int out_size, void* d_ws, size_t ws_size, hipStream_t stream) {
    static int grid = 0;
    if (grid == 0) {
        if (n_in != 27 || in_sizes[0] != T * DM || out_size != T * DM || ws_size < WS_END) { fprintf(stderr, "kernel_launch: unexpected shapes (n_in %d, in0 %d, out %d, ws %zu)\n", n_in, n_in > 0 ? in_sizes[0] : -1, out_size, ws_size); grid = -1; return; }
        int dev = 0, cus = 0;
        if (hipGetDevice(&dev) != hipSuccess || hipDeviceGetAttribute(&cus, hipDeviceAttributeMultiprocessorCount, dev) != hipSuccess) { grid = -1; return; }
        (void)hipFuncSetAttribute((const void*)mix1_naive_kernel, hipFuncAttributeMaxDynamicSharedMemorySize, LDS_BYTES);
        if (hipFuncSetAttribute((const void*)mega, hipFuncAttributeMaxDynamicSharedMemorySize, LDS_BYTES) != hipSuccess) { fprintf(stderr, "kernel_launch: hipFuncSetAttribute failed\n"); grid = -1; return; }
        int per_cu = 0;
        if (hipOccupancyMaxActiveBlocksPerMultiprocessor(&per_cu, (const void*)mega, NTHR, LDS_BYTES) != hipSuccess || per_cu < 1) fprintf(stderr, "kernel_launch: occupancy query says %d\n", per_cu);
        (void)hipGetLastError();
        grid = cus;
    }
    if (grid < 0) return;
    (void)hipMemsetAsync((char*)d_ws + WS_CTL, 0, CTL_ZERO_BYTES, stream);
    Args a{};
    for (int i = 0; i < 27; ++i) a.in[i] = (const float*)d_in[i];
    a.out = (float*)d_out; a.ws = (unsigned char*)d_ws;
#if MK_ONE_LAUNCH == 1
    a.ph_lo = 0; a.ph_hi = N_PHASES;
    hipLaunchKernelGGL(mega, dim3(grid), dim3(NTHR), LDS_BYTES, stream, a);
#elif MK_ONE_LAUNCH == 2
    { const int cuts[4] = {0, 2, 14, N_PHASES};
      for (int s = 0; s < 3; ++s) { a.ph_lo = cuts[s] + (s ? 1 : 0); a.ph_hi = cuts[s + 1]; a.li = s;
          hipLaunchKernelGGL(mega, dim3(grid), dim3(NTHR), LDS_BYTES, stream, a);
          if (s < 2) hipLaunchKernelGGL(mix1_naive_kernel, dim3(grid), dim3(NTHR), LDS_BYTES, stream, a, s); } }
#else
    const int mix1_l0 = 2 + (PROBE ? 1 : 0), mix1_l1 = mix1_l0 + 10 + (PROBE ? 6 : 0);
    for (int p = 0; p < N_PHASES; ++p) {
        if (p == mix1_l0 || p == mix1_l1) { hipLaunchKernelGGL(mix1_naive_kernel, dim3(grid), dim3(NTHR), LDS_BYTES, stream, a, p == mix1_l0 ? 0 : 1); continue; }
        a.ph_lo = p; a.ph_hi = p + 1; hipLaunchKernelGGL(mega, dim3(grid), dim3(NTHR), LDS_BYTES, stream, a); }
#endif
}
```
